# Optimizing an MI355X kernel written in HIP

```python
import math
import jax, jax.numpy as jnp
from jax import lax
import numpy as np

D_MODEL = 1024
BATCH = 2
SEQ = 8192
DEPTH = 4

N_MIXERS = 3
HEAD_DIM = 64
D_FF = 2816
RMS_EPS = 1e-6
BLOCK = 128
NEG_INF = -1e30
FFN_HALF = 0.5

A_GROUPS = ((128, 1), (512, 4), (2048, 16))
A_HEADS = D_MODEL // HEAD_DIM
A_IN = len(A_GROUPS) * 3 * A_HEADS * HEAD_DIM
B_HEADS = D_MODEL // (2 * HEAD_DIM)
B_IN = 3 * D_MODEL
C_HEADS = D_MODEL // HEAD_DIM
C_KV_HEADS = C_HEADS // 8
C_WINDOW = 128
C_IN = (C_HEADS + 2 * C_KV_HEADS) * HEAD_DIM

N_A = (DEPTH + 2) // 3
N_B = (DEPTH + 1) // 3
N_C = DEPTH // 3

kernel_name = "hybrid_interleaved_dilated_diff_swa_macaron"


def rms_norm(x, g):
    xf = x.astype(jnp.float32)
    y = xf * lax.rsqrt(jnp.mean(xf * xf, axis=-1, keepdims=True) + RMS_EPS)
    return (y * g.astype(jnp.float32)).astype(x.dtype)


def alibi_slopes(n_heads):
    return jnp.asarray(np.array([2.0 ** (-8.0 * (h + 1) / n_heads) for h in range(n_heads)], dtype=np.float32))


def swiglu(x, w_gate, w_up, w_down):
    return (jax.nn.silu(x @ w_gate) * (x @ w_up)) @ w_down


def diff_lambda_init(layer_idx):
    return 0.8 - 0.6 * math.exp(-0.3 * layer_idx)


def banded_attention(q, k, v, slopes, max_dist, sinks=None):
    b, l, hq, dh = q.shape
    hkv = k.shape[2]
    g = hq // hkv
    nb = -(-l // BLOCK)
    pad = nb * BLOCK - l
    padl = lambda t: jnp.pad(t, ((0, 0), (0, pad), (0, 0), (0, 0)))
    qb = padl(q).reshape(b, nb, BLOCK, hkv, g, dh)
    kb = padl(k).reshape(b, nb, BLOCK, hkv, dh)
    vb = padl(v).reshape(b, nb, BLOCK, hkv, dh)

    def with_prev(t):
        prev = jnp.pad(t, ((0, 0), (1, 0), (0, 0), (0, 0), (0, 0)))[:, :nb]
        return jnp.concatenate([prev, t], axis=2)

    kw, vw = with_prev(kb), with_prev(vb)
    scores = jnp.einsum('bnqhgd,bnkhd->bnhgqk', qb, kw).astype(jnp.float32) * (dh ** -0.5)
    kj = jnp.arange(2 * BLOCK)[None, :]
    dist = (jnp.arange(BLOCK)[:, None] + BLOCK) - kj
    key_pos = jnp.arange(nb)[:, None, None] * BLOCK - BLOCK + kj[None]
    valid = (dist >= 0) & (dist <= max_dist) & (key_pos >= 0)
    sl = slopes.astype(jnp.float32).reshape(hkv, g, 1, 1)
    scores = scores - sl * dist.astype(jnp.float32)
    scores = jnp.where(valid[None, :, None, None], scores, NEG_INF)
    m = jnp.max(scores, axis=-1)
    if sinks is not None:
        sink = sinks.astype(jnp.float32).reshape(1, 1, hkv, g, 1)
        m = jnp.maximum(m, sink)
    p = jnp.exp(scores - m[..., None])
    denom = jnp.sum(p, axis=-1)
    if sinks is not None:
        denom = denom + jnp.exp(sink - m)
    o = jnp.einsum('bnhgqk,bnkhd->bnqhgd', p / denom[..., None], vw.astype(jnp.float32))
    lse = m + jnp.log(denom)
    o = o.reshape(b, nb * BLOCK, hq, dh)[:, :l]
    lse = lse.transpose(0, 1, 4, 2, 3).reshape(b, nb * BLOCK, hq)[:, :l]
    return o, lse


def dilated_attention(h, w_in, w_out):
    b, s, _ = h.shape
    proj = (h @ w_in).reshape(b, s, len(A_GROUPS), 3, A_HEADS, HEAD_DIM)
    slopes = alibi_slopes(A_HEADS)
    outs, lses = [], []
    for gi, (window, dil) in enumerate(A_GROUPS):
        def to_classes(t):
            return t.reshape(b, s // dil, dil, A_HEADS, HEAD_DIM).transpose(0, 2, 1, 3, 4).reshape(b * dil, s // dil, A_HEADS, HEAD_DIM)
        q, k, v = (to_classes(proj[:, :, gi, c]) for c in range(3))
        o, lse = banded_attention(q, k, v, slopes * dil, window // dil)
        outs.append(o.reshape(b, dil, s // dil, A_HEADS, HEAD_DIM).transpose(0, 2, 1, 3, 4).reshape(b, s, A_HEADS, HEAD_DIM))
        lses.append(lse.reshape(b, dil, s // dil, A_HEADS).transpose(0, 2, 1, 3).reshape(b, s, A_HEADS))
    wts = jax.nn.softmax(jnp.stack(lses, axis=0), axis=0)
    o = jnp.sum(wts[..., None] * jnp.stack(outs, axis=0), axis=0)
    return o.reshape(b, s, A_HEADS * HEAD_DIM).astype(h.dtype) @ w_out


def diff_attention(h, w_in, w_out, lam, subln_g, lambda_init):
    b, s, _ = h.shape
    proj = h @ w_in
    q = proj[..., :D_MODEL].reshape(b, s, B_HEADS, 2, HEAD_DIM)
    k = proj[..., D_MODEL:2 * D_MODEL].reshape(b, s, B_HEADS, 2, HEAD_DIM)
    v = proj[..., 2 * D_MODEL:].reshape(b, s, B_HEADS, 2 * HEAD_DIM)
    lamf = lam.astype(jnp.float32)
    lam_full = jnp.exp(jnp.sum(lamf[0] * lamf[1])) - jnp.exp(jnp.sum(lamf[2] * lamf[3])) + lambda_init
    slopes = alibi_slopes(B_HEADS)[:, None, None, None]
    nb = s // BLOCK
    qb = q.reshape(b, nb, BLOCK, B_HEADS, 2, HEAD_DIM).transpose(1, 0, 2, 3, 4, 5)
    kpos = jnp.arange(s)
    scale = HEAD_DIM ** -0.5

    def block_fn(args):
        qblk, n = args
        qpos = n * BLOCK + jnp.arange(BLOCK)
        sc = jnp.einsum('bqhcd,bkhcd->bhcqk', qblk, k).astype(jnp.float32) * scale
        dist = qpos[:, None] - kpos[None, :]
        sc = jnp.where(dist >= 0, sc - slopes * dist.astype(jnp.float32), NEG_INF)
        p = jax.nn.softmax(sc, axis=-1)
        a = p[:, :, 0] - lam_full * p[:, :, 1]
        return jnp.einsum('bhqk,bkhe->bqhe', a, v.astype(jnp.float32))

    o = lax.map(block_fn, (qb, jnp.arange(nb)))
    o = o.transpose(1, 0, 2, 3, 4).reshape(b, s, B_HEADS, 2 * HEAD_DIM)
    o = rms_norm(o, subln_g) * (1.0 - lambda_init)
    return o.reshape(b, s, D_MODEL).astype(h.dtype) @ w_out


def swa_sink_attention(h, w_in, b_in, w_out, sinks):
    b, s, _ = h.shape
    proj = h @ w_in + b_in
    nq, nk = C_HEADS * HEAD_DIM, C_KV_HEADS * HEAD_DIM
    q = proj[..., :nq].reshape(b, s, C_HEADS, HEAD_DIM)
    k = proj[..., nq:nq + nk].reshape(b, s, C_KV_HEADS, HEAD_DIM)
    v = proj[..., nq + nk:].reshape(b, s, C_KV_HEADS, HEAD_DIM)
    o, _ = banded_attention(q, k, v, alibi_slopes(C_HEADS), C_WINDOW - 1, sinks)
    return o.reshape(b, s, nq).astype(h.dtype) @ w_out


def setup_inputs(seed: int = 0) -> dict:
    key = jax.random.key(seed)
    ks = jax.random.split(key, 16)
    nrm = lambda k, shape, sc: jax.random.normal(k, shape, jnp.float32) * sc
    return {
        "x": nrm(ks[0], (BATCH, SEQ, D_MODEL), 1.0),
        "norm_pre": 1.0 + nrm(ks[1], (DEPTH, 3, D_MODEL), 0.02),
        "norm_post": 1.0 + nrm(ks[2], (DEPTH, 3, D_MODEL), 0.02),
        "ffn_w_gate": nrm(ks[3], (DEPTH, 2, D_MODEL, D_FF), D_MODEL ** -0.5),
        "ffn_w_up": nrm(ks[4], (DEPTH, 2, D_MODEL, D_FF), D_MODEL ** -0.5),
        "ffn_w_down": nrm(ks[5], (DEPTH, 2, D_FF, D_MODEL), D_FF ** -0.5),
        "a_w_in": nrm(ks[6], (N_A, D_MODEL, A_IN), D_MODEL ** -0.5),
        "a_w_out": nrm(ks[7], (N_A, A_HEADS * HEAD_DIM, D_MODEL), (A_HEADS * HEAD_DIM) ** -0.5),
        "b_w_in": nrm(ks[8], (N_B, D_MODEL, B_IN), D_MODEL ** -0.5),
        "b_w_out": nrm(ks[9], (N_B, D_MODEL, D_MODEL), D_MODEL ** -0.5),
        "b_lambda": nrm(ks[10], (N_B, 4, HEAD_DIM), 0.1),
        "b_subln": 1.0 + nrm(ks[11], (N_B, 2 * HEAD_DIM), 0.02),
        "c_w_in": nrm(ks[12], (N_C, D_MODEL, C_IN), D_MODEL ** -0.5),
        "c_b_in": nrm(ks[13], (N_C, C_IN), 0.02),
        "c_w_out": nrm(ks[14], (N_C, C_HEADS * HEAD_DIM, D_MODEL), (C_HEADS * HEAD_DIM) ** -0.5),
        "c_sinks": nrm(ks[15], (N_C, C_HEADS), 0.5),
    }


def reference(x, norm_pre, norm_post, ffn_w_gate, ffn_w_up, ffn_w_down, a_w_in, a_w_out, b_w_in, b_w_out, b_lambda, b_subln, c_w_in, c_b_in, c_w_out, c_sinks):
    for i in range(DEPTH):
        f = swiglu(rms_norm(x, norm_pre[i, 0]), ffn_w_gate[i, 0], ffn_w_up[i, 0], ffn_w_down[i, 0])
        x = x + FFN_HALF * rms_norm(f, norm_post[i, 0])
        hn = rms_norm(x, norm_pre[i, 1])
        kind, j = i % N_MIXERS, i // N_MIXERS
        if kind == 0:
            m = dilated_attention(hn, a_w_in[j], a_w_out[j])
        elif kind == 1:
            m = diff_attention(hn, b_w_in[j], b_w_out[j], b_lambda[j], b_subln[j], diff_lambda_init(i))
        else:
            m = swa_sink_attention(hn, c_w_in[j], c_b_in[j], c_w_out[j], c_sinks[j])
        x = x + rms_norm(m, norm_post[i, 1])
        f = swiglu(rms_norm(x, norm_pre[i, 2]), ffn_w_gate[i, 1], ffn_w_up[i, 1], ffn_w_down[i, 1])
        x = x + FFN_HALF * rms_norm(f, norm_post[i, 2])
    return x
```

```cpp
#include <hip/hip_runtime.h>
#include <hip/hip_cooperative_groups.h>
#include <cstdio>
#include <cstdint>
#include <cmath>
__device__ __forceinline__ int opaque_tid() { int t = threadIdx.x; asm volatile("" : "+v"(t)); return t; }
namespace pg8 {
#define PG8_LAS __attribute__((address_space(3)))
typedef unsigned short bf16_t;
typedef short bf16x8 __attribute__((ext_vector_type(8)));
typedef float f32x4 __attribute__((ext_vector_type(4)));
typedef unsigned u32x4 __attribute__((ext_vector_type(4)));
constexpr int BM = 256, BK = 64, HALF = 128, HTB = HALF * BK * 2  , STAGE_BYTES = 8 * HTB, NXCD = 8, WGM = 8;

__host__ __device__ __forceinline__ int lds_byte(int r, int c) { const int st = (r >> 4) * 2 + (c >> 5), rr = r & 15, cc = c & 31, ob = rr * 64 + cc * 2; return st * 1024 + (ob ^ (((ob >> 9) & 1) << 5)); }
__host__ __device__ __forceinline__ void stage_rc(int b, int& R, int& C) { const int st = b / 1024, sb = b % 1024, swz = sb ^ (((sb >> 9) & 1) << 5); R = (st >> 1) * 16 + swz / 64; C = (st & 1) * 32 + (swz % 64) / 2; }
__host__ __device__ __forceinline__ int perm32(int rho) { const int n = rho >> 4, i = rho & 15; return 8 * (i >> 2) + 4 * n + (i & 3); }

struct Unit { int pm, pn; };
struct Gemm { const bf16_t* A; const bf16_t* Bt; int M, N, K; };

struct StaticOrder {
    int nM, nN, nwg, G, c;
    __host__ __device__ void init(int M, int N, int G_, int c_) { nM = M / BM; nN = N / BM; nwg = nM * nN; G = G_; c = c_; }
    __host__ __device__ bool next(int i, Unit& u) const {
        const long L = (long)i * G + c; if (L >= nwg) return false;
        int wgid = (int)L; { const int q = nwg / NXCD, r = nwg % NXCD, xcd = wgid % NXCD, off = wgid / NXCD; wgid = (xcd < r ? xcd * (q + 1) : r * (q + 1) + (xcd - r) * q) + off; }
        const int nig = WGM * nN, gid = wgid / nig, fm = gid * WGM, gsz = (nM - fm) < WGM ? (nM - fm) : WGM;
        u.pm = fm + ((wgid % nig) % gsz); u.pn = (wgid % nig) / gsz; return true;
    }
    __device__ __forceinline__ void a_ready(const Unit&) const {}
    __device__ __forceinline__ void done(const Unit&) const {}
};


typedef float f32x2 __attribute__((ext_vector_type(2)));
typedef __bf16 bf16x2_t __attribute__((ext_vector_type(2)));
__device__ __forceinline__ unsigned cvt_pk_bf16(float lo, float hi) { f32x2 v = {lo, hi}; bf16x2_t b = __builtin_convertvector(v, bf16x2_t); return __builtin_bit_cast(unsigned, b); }

struct EpiProj {
    static constexpr bool PERM = true, AFTER_DRAIN = false;
    bf16_t* O; int ldc; const float* bias; float qscale;
    __device__ __forceinline__ void operator()(const f32x4 (&acc)[2][2][4][2], const Unit& u, int wr, int wc, int fr, int fq) const {
        const int row0 = u.pm * BM + wr * 64 + fr; const int colt = u.pn * BM;
        const float sc = (((colt >> 10) % 3) == 0) ? qscale : 1.f;
        const int col0 = colt + wc * 32 + 8 * fq;
        f32x4 bv[2][2];
#pragma unroll
        for (int bj = 0; bj < 2; ++bj)
#pragma unroll
            for (int n = 0; n < 2; ++n) bv[bj][n] = bias ? *(const f32x4*)(bias + col0 + bj * HALF + 4 * n) : (f32x4){0.f, 0.f, 0.f, 0.f};
#pragma unroll
        for (int ai = 0; ai < 2; ++ai)
#pragma unroll
            for (int m = 0; m < 4; ++m) { bf16_t* rowp = O + (size_t)(row0 + ai * HALF + m * 16) * ldc + col0;
#pragma unroll
                for (int bj = 0; bj < 2; ++bj) { f32x4 v0 = (acc[ai][bj][m][0] + bv[bj][0]) * sc, v1 = (acc[ai][bj][m][1] + bv[bj][1]) * sc;
                    u32x4 w; w.x = cvt_pk_bf16(v0[0], v0[1]); w.y = cvt_pk_bf16(v0[2], v0[3]); w.z = cvt_pk_bf16(v1[0], v1[1]); w.w = cvt_pk_bf16(v1[2], v1[3]);
                    *(u32x4*)(rowp + bj * HALF) = w; } }
    }
};

struct EpiSwiGLU {
    static constexpr bool PERM = true, AFTER_DRAIN = false;
    bf16_t* O; int ldc;
    __device__ __forceinline__ void operator()(const f32x4 (&acc)[2][2][4][2], const Unit& u, int wr, int wc, int fr, int fq) const {
        const int row0 = u.pm * BM + wr * 64 + fr; const int col0 = u.pn * HALF + wc * 32 + 8 * fq;
#pragma unroll
        for (int ai = 0; ai < 2; ++ai)
#pragma unroll
            for (int m = 0; m < 4; ++m) { bf16_t* rowp = O + (size_t)(row0 + ai * HALF + m * 16) * ldc + col0;
                float r[8];
#pragma unroll
                for (int n = 0; n < 2; ++n)
#pragma unroll
                    for (int j = 0; j < 4; ++j) { const float g = acc[ai][0][m][n][j], up = acc[ai][1][m][n][j];
                        const float e = __builtin_amdgcn_exp2f(g * -1.4426950408889634f);
                        r[n * 4 + j] = g * __builtin_amdgcn_rcpf(1.f + e) * up; }
                u32x4 w; w.x = cvt_pk_bf16(r[0], r[1]); w.y = cvt_pk_bf16(r[2], r[3]); w.z = cvt_pk_bf16(r[4], r[5]); w.w = cvt_pk_bf16(r[6], r[7]);
                *(u32x4*)rowp = w; }
    }
};

struct EpiF32Stats {
    static constexpr bool PERM = false, AFTER_DRAIN = false;
    float* F; int ldc; float* stats;
    __device__ __forceinline__ void operator()(const f32x4 (&acc)[2][2][4][2], const Unit& u, int wr, int wc, int fr, int fq) const {
        const int row0 = u.pm * BM + wr * 64 + fr; const int col0 = u.pn * BM + wc * 32 + 4 * fq;
#pragma unroll
        for (int ai = 0; ai < 2; ++ai)
#pragma unroll
            for (int m = 0; m < 4; ++m) { const int row = row0 + ai * HALF + m * 16; float* rowp = F + (size_t)row * ldc + col0; float s = 0.f;
#pragma unroll
                for (int bj = 0; bj < 2; ++bj)
#pragma unroll
                    for (int n = 0; n < 2; ++n) { const f32x4 v = acc[ai][bj][m][n]; s += (v[0] * v[0] + v[1] * v[1]) + (v[2] * v[2] + v[3] * v[3]); *(f32x4*)(rowp + bj * HALF + n * 16) = v; }
                s += __shfl_xor(s, 16); s += __shfl_xor(s, 32);
                if (fq == 0) stats[(size_t)row * 16 + u.pn * 4 + wc] = s; }
    }
};
template <class Epi, class Sched, bool ALIGN_EPI = false, bool SP2 = false>
__device__ __forceinline__ void gemm_phase(PG8_LAS unsigned char* lds, const Gemm g, const Sched& S, const Epi& E) {
    const int tid = opaque_tid(), wid = __builtin_amdgcn_readfirstlane(tid >> 6), lane = tid & 63, wr = wid >> 2, wc = wid & 3, fr = lane & 15, fq = lane >> 4;
    const int K = g.K, nt = K / BK;
    unsigned voffA[2], voffB[2];
#pragma unroll
    for (int i = 0; i < 2; ++i) { int R, C; stage_rc(tid * 16 + i * 8192, R, C); const int Rb = Epi::PERM ? ((R & ~31) + perm32(R & 31)) : R;
        voffA[i] = (unsigned)(R * K + C) * 2u; voffB[i] = (unsigned)(Rb * K + C) * 2u; }
    const size_t kstep = (size_t)(BK * 2);
    const size_t hstep = (size_t)HALF * K * 2;
    const size_t tstep = 2 * hstep;
    const unsigned ldsw = (unsigned)wid * 1024u;
    const int aoff = lds_byte(wr * 64 + fr, fq * 8), boff = lds_byte(wc * 32 + fr, fq * 8);
#define PG8_SA(b, h) (((b) * 2 + (h)) * HTB)
#define PG8_SB(b, h) ((4 + (b) * 2 + (h)) * HTB)
#define PG8_STAGE(bufoff, gbase, voff) do { _Pragma("unroll") for (int _i = 0; _i < 2; ++_i) \
        __builtin_amdgcn_global_load_lds((const unsigned*)((const char*)(gbase) + (voff)[_i]), (PG8_LAS unsigned*)(lds + (bufoff) + ldsw + _i * 8192), 16, 0, 0); } while (0)
#define PG8_LDA(dst, b, h) do { _Pragma("unroll") for (int m = 0; m < 4; ++m) _Pragma("unroll") for (int k = 0; k < 2; ++k) dst[m][k] = *(const PG8_LAS bf16x8*)(lds + PG8_SA(b, h) + aoff + m * 2048 + k * 1024); } while (0)
#define PG8_LDB(dst, b, h) do { _Pragma("unroll") for (int n = 0; n < 2; ++n) _Pragma("unroll") for (int k = 0; k < 2; ++k) dst[n][k] = *(const PG8_LAS bf16x8*)(lds + PG8_SB(b, h) + boff + n * 2048 + k * 1024); } while (0)
#define PG8_MMA(ai, bj, At, Bt) do { __builtin_amdgcn_s_setprio(1); _Pragma("unroll") for (int m = 0; m < 4; ++m) _Pragma("unroll") for (int n = 0; n < 2; ++n) _Pragma("unroll") for (int k = 0; k < 2; ++k) \
        acc[ai][bj][m][n] = __builtin_amdgcn_mfma_f32_16x16x32_bf16(Bt[n][k], At[m][k], acc[ai][bj][m][n], 0, 0, 0); __builtin_amdgcn_s_setprio(0); } while (0)
#define PG8_WAIT_V(n) asm volatile("s_waitcnt vmcnt(" #n ")" ::: "memory")
#define PG8_WAIT_L(n) asm volatile("s_waitcnt lgkmcnt(" #n ")" ::: "memory")
#define PG8_BAR __builtin_amdgcn_s_barrier()
#define PG8_SCHED __builtin_amdgcn_sched_barrier(0)
    Unit cur, nxt; int ui = 0;
    if (!S.next(0, cur)) return;
    f32x4 acc[2][2][4][2];
#pragma unroll
    for (int a = 0; a < 2; ++a)
#pragma unroll
        for (int b = 0; b < 2; ++b)
#pragma unroll
            for (int m = 0; m < 4; ++m)
#pragma unroll
                for (int n = 0; n < 2; ++n) acc[a][b][m][n] = (f32x4){0.f, 0.f, 0.f, 0.f};
    bf16x8 At[4][2], B0[2][2], B1[2][2];
    const char* cA = (const char*)g.A + (size_t)cur.pm * tstep; const char* cB = (const char*)g.Bt + (size_t)cur.pn * tstep;
    S.a_ready(cur);
    if constexpr (SP2) {
        PG8_STAGE(PG8_SB(0, 0), cB, voffB); PG8_STAGE(PG8_SB(0, 1), cB + hstep, voffB); PG8_STAGE(PG8_SA(0, 0), cA, voffA); PG8_STAGE(PG8_SA(0, 1), cA + hstep, voffA);
        if (wr == 1) PG8_BAR;
        PG8_WAIT_V(2); PG8_BAR;
        PG8_STAGE(PG8_SB(1, 0), cB + kstep, voffB); PG8_STAGE(PG8_SA(1, 0), cA + kstep, voffA); PG8_STAGE(PG8_SB(1, 1), cB + hstep + kstep, voffB);
        PG8_WAIT_V(6); PG8_BAR;
    } else {
        PG8_STAGE(PG8_SB(0, 0), cB, voffB); PG8_STAGE(PG8_SA(0, 0), cA, voffA); PG8_STAGE(PG8_SB(0, 1), cB + hstep, voffB); PG8_STAGE(PG8_SA(0, 1), cA + hstep, voffA);
        if (wr == 1) PG8_BAR;
        PG8_WAIT_V(4); PG8_BAR;
        PG8_STAGE(PG8_SB(1, 0), cB + kstep, voffB); PG8_STAGE(PG8_SA(1, 0), cA + kstep, voffA); PG8_STAGE(PG8_SB(1, 1), cB + hstep + kstep, voffB);
        PG8_WAIT_V(6); PG8_BAR;
    }
    for (;;) {
        const bool has_next = S.next(ui + 1, nxt);
        const char* nA = has_next ? (const char*)g.A + (size_t)nxt.pm * tstep : cA; const char* nB = has_next ? (const char*)g.Bt + (size_t)nxt.pn * tstep : cB;
        for (int t = 0; t < nt; t += 2) {
            const bool last = (t == nt - 2);
            const char* a1 = cA + (size_t)(t + 1) * kstep;
            const char* a2 = last ? nA : cA + (size_t)(t + 2) * kstep; const char* b2 = last ? nB : cB + (size_t)(t + 2) * kstep;
            const char* a3 = a2 + kstep; const char* b3 = b2 + kstep;
            if (last && has_next) S.a_ready(nxt);
            if constexpr (SP2) {
            PG8_LDB(B0, 0, 0); PG8_LDB(B1, 0, 1); PG8_SCHED; PG8_LDA(At, 0, 0); PG8_STAGE(PG8_SA(1, 1), a1 + hstep, voffA);
            PG8_WAIT_V(8); PG8_WAIT_L(0); PG8_BAR; PG8_MMA(0, 0, At, B0); PG8_MMA(0, 1, At, B1); PG8_BAR; PG8_SCHED;
            PG8_LDA(At, 0, 1); PG8_STAGE(PG8_SB(0, 0), b2, voffB); PG8_STAGE(PG8_SB(0, 1), b2 + hstep, voffB); PG8_STAGE(PG8_SA(0, 0), a2, voffA);
            PG8_WAIT_V(8); PG8_WAIT_L(0); PG8_BAR; PG8_MMA(1, 0, At, B0); PG8_MMA(1, 1, At, B1); PG8_BAR; PG8_SCHED;
            PG8_LDB(B0, 1, 0); PG8_LDB(B1, 1, 1); PG8_SCHED; PG8_LDA(At, 1, 0); PG8_STAGE(PG8_SA(0, 1), a2 + hstep, voffA);
            PG8_WAIT_V(8); PG8_WAIT_L(0); PG8_BAR; PG8_MMA(0, 0, At, B0); PG8_MMA(0, 1, At, B1); PG8_BAR; PG8_SCHED;
            PG8_LDA(At, 1, 1); PG8_STAGE(PG8_SB(1, 0), b3, voffB); PG8_STAGE(PG8_SB(1, 1), b3 + hstep, voffB); PG8_STAGE(PG8_SA(1, 0), a3, voffA);
            PG8_WAIT_V(8); PG8_WAIT_L(0); PG8_BAR; PG8_MMA(1, 0, At, B0); PG8_MMA(1, 1, At, B1); PG8_BAR; PG8_SCHED;
            } else {
            PG8_LDB(B0, 0, 0); PG8_SCHED; PG8_LDA(At, 0, 0); PG8_STAGE(PG8_SA(1, 1), a1 + hstep, voffA);
            PG8_WAIT_L(8); PG8_BAR; PG8_WAIT_L(0); PG8_MMA(0, 0, At, B0); PG8_BAR; PG8_SCHED;
            PG8_LDB(B1, 0, 1); PG8_STAGE(PG8_SB(0, 0), b2, voffB);
            PG8_BAR; PG8_WAIT_L(0); PG8_MMA(0, 1, At, B1); PG8_BAR;
            PG8_LDA(At, 0, 1); PG8_STAGE(PG8_SA(0, 0), a2, voffA);
            PG8_BAR; PG8_WAIT_L(0); PG8_MMA(1, 0, At, B0); PG8_BAR; PG8_SCHED;
            PG8_STAGE(PG8_SB(0, 1), b2 + hstep, voffB);
            PG8_WAIT_V(6); PG8_BAR; PG8_MMA(1, 1, At, B1); PG8_BAR;
            PG8_LDB(B0, 1, 0); PG8_SCHED; PG8_LDA(At, 1, 0); PG8_STAGE(PG8_SA(0, 1), a2 + hstep, voffA);
            PG8_WAIT_L(8); PG8_BAR; PG8_WAIT_L(0); PG8_MMA(0, 0, At, B0); PG8_BAR; PG8_SCHED;
            PG8_LDB(B1, 1, 1); PG8_STAGE(PG8_SB(1, 0), b3, voffB);
            PG8_BAR; PG8_WAIT_L(0); PG8_MMA(0, 1, At, B1); PG8_BAR;
            PG8_LDA(At, 1, 1); PG8_STAGE(PG8_SA(1, 0), a3, voffA);
            PG8_BAR; PG8_WAIT_L(0); PG8_MMA(1, 0, At, B0); PG8_BAR; PG8_SCHED;
            PG8_STAGE(PG8_SB(1, 1), b3 + hstep, voffB);
            PG8_WAIT_V(6); PG8_BAR; PG8_MMA(1, 1, At, B1); PG8_BAR;
            }
        }
        if constexpr (ALIGN_EPI) { if (wr == 0) PG8_BAR; }
        if constexpr (!Epi::AFTER_DRAIN) { E(acc, cur, wr, wc, fr, fq); S.done(cur); }
        if (!has_next) break;
#pragma unroll
        for (int a = 0; a < 2; ++a)
#pragma unroll
            for (int b = 0; b < 2; ++b)
#pragma unroll
                for (int m = 0; m < 4; ++m)
#pragma unroll
                    for (int n = 0; n < 2; ++n) acc[a][b][m][n] = (f32x4){0.f, 0.f, 0.f, 0.f};
        cur = nxt; cA = nA; cB = nB; ++ui;
        if constexpr (ALIGN_EPI) { if (wr == 1) PG8_BAR; }
    }
    PG8_WAIT_V(0);
    if constexpr (!ALIGN_EPI) { if (wr == 0) PG8_BAR; }
    PG8_BAR;
    if constexpr (Epi::AFTER_DRAIN) { E.fused(acc, cur, wr, wc, fr, fq, lds, wid, lane); S.done(cur); }
#undef PG8_SA
#undef PG8_SB
#undef PG8_STAGE
#undef PG8_LDA
#undef PG8_LDB
#undef PG8_MMA
#undef PG8_WAIT_V
#undef PG8_WAIT_L
#undef PG8_BAR
#undef PG8_SCHED
}
}

namespace att {
typedef unsigned short bf16_t;
typedef short bf16x8 __attribute__((ext_vector_type(8)));
typedef short s16x4 __attribute__((ext_vector_type(4)));
typedef float f32x16 __attribute__((ext_vector_type(16)));
typedef float f32x4 __attribute__((ext_vector_type(4)));
typedef unsigned u32x4 __attribute__((ext_vector_type(4)));
typedef unsigned u32x2 __attribute__((ext_vector_type(2)));
#define ATT_LAS __attribute__((address_space(3)))
constexpr int KROWB = 144;
constexpr int VROWB = 136;
constexpr int KBYTES = 64 * KROWB;
template <int DV> struct Geo { static constexpr int VBYTES = DV * VROWB, BUF = KBYTES + VBYTES; };
typedef __bf16 bf16x2_t __attribute__((ext_vector_type(2)));
typedef float f32x2 __attribute__((ext_vector_type(2)));
__device__ __forceinline__ unsigned pk2(float lo, float hi) { f32x2 v = {lo, hi}; bf16x2_t b = __builtin_convertvector(v, bf16x2_t); return __builtin_bit_cast(unsigned, b); }
__device__ __forceinline__ int crow(int r, int hi) { return (r & 3) + 8 * (r >> 2) + 4 * hi; }

template <int DV>
__device__ __forceinline__ void core(ATT_LAS unsigned char* lds, const bf16_t* __restrict__ qp, const bf16_t* __restrict__ kp, const bf16_t* __restrict__ vp, long stride,
                                     int n0, int kt_lo, int kt_hi, int max_dist, float slope2, f32x16 (&o)[DV / 32], float& m, float& l) {
    const int tid = opaque_tid(), lane = tid & 63, l32 = lane & 31, hi = lane >> 5; const int wid = __builtin_amdgcn_readfirstlane(tid >> 6);
    const int wq0 = n0 + wid * 32, qi = wq0 + l32;
    bf16x8 qf[4];
#pragma unroll
    for (int s = 0; s < 4; ++s) qf[s] = *(const bf16x8*)(qp + (long)qi * stride + s * 16 + hi * 8);
#pragma unroll
    for (int d0 = 0; d0 < DV / 32; ++d0)
#pragma unroll
        for (int r = 0; r < 16; ++r) o[d0][r] = 0.f;
    const int kkey = tid >> 3, kch = tid & 7;
    const bf16_t* kg = kp + (long)kkey * stride + kch * 8;
    const bf16_t* vg = vp + (long)lane * stride + wid * 8;
    const long tstep = 64 * stride;
    u32x4 kreg, vreg[DV / 64];
    kreg = *(const u32x4*)(kg + (long)kt_lo * tstep);
#pragma unroll
    for (int j = 0; j < DV / 64; ++j) vreg[j] = *(const u32x4*)(vg + (long)kt_lo * tstep + j * 64);
    int cur = 0;
    for (int kt = kt_lo; kt < kt_hi; ++kt) {
        ATT_LAS unsigned char* Kb = lds + cur * Geo<DV>::BUF; ATT_LAS unsigned char* Vb = Kb + KBYTES;
        *(ATT_LAS u32x4*)(Kb + kkey * KROWB + kch * 16) = kreg;
#pragma unroll
        for (int j = 0; j < DV / 64; ++j) {
            const int dbase = (wid + 8 * j) * 8;
#pragma unroll
            for (int e = 0; e < 4; ++e) {
                const unsigned w = vreg[j][e];
                *(ATT_LAS unsigned short*)(Vb + (dbase + 2 * e) * VROWB + lane * 2) = (unsigned short)(w & 0xffffu);
                *(ATT_LAS unsigned short*)(Vb + (dbase + 2 * e + 1) * VROWB + lane * 2) = (unsigned short)(w >> 16);
            }
        }
        __syncthreads();
        if (kt + 1 < kt_hi) {
            kreg = *(const u32x4*)(kg + (long)(kt + 1) * tstep);
#pragma unroll
            for (int j = 0; j < DV / 64; ++j) vreg[j] = *(const u32x4*)(vg + (long)(kt + 1) * tstep + j * 64);
        }
        const int k0 = kt * 64;
        const bool relevant = (k0 <= wq0 + 31) && (k0 + 63 >= wq0 - max_dist);
        if (relevant) {
            f32x16 s0, s1;
#pragma unroll
            for (int r = 0; r < 16; ++r) { s0[r] = 0.f; s1[r] = 0.f; }
#pragma unroll
            for (int s = 0; s < 4; ++s) {
                const bf16x8 ka = *(const ATT_LAS bf16x8*)(Kb + l32 * KROWB + s * 32 + hi * 16);
                const bf16x8 kb = *(const ATT_LAS bf16x8*)(Kb + (32 + l32) * KROWB + s * 32 + hi * 16);
                s0 = __builtin_amdgcn_mfma_f32_32x32x16_bf16(ka, qf[s], s0, 0, 0, 0);
                s1 = __builtin_amdgcn_mfma_f32_32x32x16_bf16(kb, qf[s], s1, 0, 0, 0);
            }
            const int rel0 = k0 + 4 * hi - qi;
            const float relf = (float)rel0;
#pragma unroll
            for (int r = 0; r < 16; ++r) {
                const float c = (float)((r & 3) + 8 * (r >> 2));
                s0[r] = s0[r] + slope2 * (relf + c);
                s1[r] = s1[r] + slope2 * (relf + c + 32.f);
            }
            const bool need_mask = (k0 + 63 > wq0) || (k0 < wq0 + 31 - max_dist);
            if (need_mask) {
#pragma unroll
                for (int r = 0; r < 16; ++r) {
                    const int rel = rel0 + (r & 3) + 8 * (r >> 2);
                    if (rel > 0 || rel < -max_dist) s0[r] = -INFINITY;
                    if (rel + 32 > 0 || rel + 32 < -max_dist) s1[r] = -INFINITY;
                }
            }
            float mx = fmaxf(s0[0], s1[0]);
#pragma unroll
            for (int r = 1; r < 16; ++r) mx = fmaxf(mx, fmaxf(s0[r], s1[r]));
            mx = fmaxf(mx, __shfl_xor(mx, 32));
            const float mnew = fmaxf(m, mx);
            const float alpha = __builtin_amdgcn_exp2f(m - mnew);
            m = mnew;
            float ps = 0.f;
#pragma unroll
            for (int r = 0; r < 16; ++r) { s0[r] = __builtin_amdgcn_exp2f(s0[r] - mnew); s1[r] = __builtin_amdgcn_exp2f(s1[r] - mnew); ps += s0[r] + s1[r]; }
            l = l * alpha + ps;
#pragma unroll
            for (int d0 = 0; d0 < DV / 32; ++d0)
#pragma unroll
                for (int r = 0; r < 16; ++r) o[d0][r] *= alpha;
            u32x4 pw[4];
#pragma unroll
            for (int e = 0; e < 4; ++e) {
                pw[0][e] = pk2(s0[2 * e], s0[2 * e + 1]); pw[1][e] = pk2(s0[8 + 2 * e], s0[8 + 2 * e + 1]);
                pw[2][e] = pk2(s1[2 * e], s1[2 * e + 1]); pw[3][e] = pk2(s1[8 + 2 * e], s1[8 + 2 * e + 1]);
            }
#pragma unroll
            for (int ks = 0; ks < 4; ++ks) {
                const bf16x8 pf = __builtin_bit_cast(bf16x8, pw[ks]);
#pragma unroll
                for (int d0 = 0; d0 < DV / 32; ++d0) {
                    const ATT_LAS unsigned char* vr = Vb + (d0 * 32 + l32) * VROWB + (ks * 16 + 4 * hi) * 2;
                    const s16x4 lo = *(const ATT_LAS s16x4*)(vr), hh = *(const ATT_LAS s16x4*)(vr + 16);
                    const bf16x8 vf = (bf16x8){lo[0], lo[1], lo[2], lo[3], hh[0], hh[1], hh[2], hh[3]};
                    o[d0] = __builtin_amdgcn_mfma_f32_32x32x16_bf16(vf, pf, o[d0], 0, 0, 0);
                }
            }
        }
        cur ^= 1;
    }
    __syncthreads();
}
}

namespace cg = cooperative_groups;
typedef unsigned short bf16;
typedef float f32x4 __attribute__((ext_vector_type(4)));
typedef unsigned v4u __attribute__((ext_vector_type(4)));
typedef unsigned v2u __attribute__((ext_vector_type(2)));
#define LAS __attribute__((address_space(3)))
constexpr int NWAVES = 8;
constexpr int BATCH = 2, SEQ = 8192, D = 1024, DFF = 2816, M = BATCH * SEQ, DEPTH = 4;
constexpr float RMS_EPS = 1e-6f, LOG2E = 1.4426950408889634f, QSCALE = 0.125f * LOG2E;
constexpr size_t MiB = 1u << 20;
constexpr size_t WS_W = 0, WS_BIG = 185 * MiB, WS_H = 281 * MiB, WS_F = 313 * MiB, WS_O = 377 * MiB, WS_STATS = 409 * MiB, WS_LSE = 410 * MiB, WS_END = 411 * MiB;
constexpr size_t W_GU = (size_t)2 * DFF * D, W_DN = (size_t)D * DFF, W_FFN = W_GU + W_DN;
constexpr size_t WO_AIN = 8 * W_FFN, W_AIN = (size_t)9216 * D, WO_AOUT = WO_AIN + 2 * W_AIN, W_SQ = (size_t)D * D;
constexpr size_t WO_BIN = WO_AOUT + 2 * W_SQ, W_BIN = (size_t)3072 * D, WO_BOUT = WO_BIN + W_BIN, WO_CIN = WO_BOUT + W_SQ, W_CIN = (size_t)1280 * D, WO_COUT = WO_CIN + W_CIN, WO_END = WO_COUT + W_SQ;
static_assert(WO_END * 2 <= WS_BIG, "weights fit");
constexpr int LDS_BYTES = 131072 + 1024;

__device__ __forceinline__ float wave_sum(float v) {
#pragma unroll
    for (int o = 1; o < 64; o <<= 1) v += __shfl_xor(v, o);
    return v;
}
__device__ __forceinline__ unsigned pk2(float lo, float hi) { return att::pk2(lo, hi); }

__device__ __forceinline__ void transpose_item(const float* __restrict__ W, int K, int N, bf16* WT, LAS float* scr, int item, int lane, int mode) {
    const int nblk = N / 32, kb = item / nblk, nb = item % nblk, k0 = 64 * kb, n0 = 32 * nb;
    int drow0 = n0;
    if (mode) drow0 = 256 * (n0 >> 7) + (n0 & 127) + (mode == 2 ? 128 : 0);
#pragma unroll 8
    for (int i = 0; i < 32; ++i) { const int kk = 2 * i + (lane >> 5); scr[kk * 33 + (lane & 31)] = W[(size_t)(k0 + kk) * N + n0 + (lane & 31)]; }
    asm volatile("s_waitcnt lgkmcnt(0)" ::: "memory");
    const int c = lane & 7;
#pragma unroll
    for (int j = 0; j < 4; ++j) { const int n = (lane >> 3) + 8 * j; const LAS float* s = scr + (8 * c) * 33 + n;
        v4u o; o.x = pk2(s[0 * 33], s[1 * 33]); o.y = pk2(s[2 * 33], s[3 * 33]); o.z = pk2(s[4 * 33], s[5 * 33]); o.w = pk2(s[6 * 33], s[7 * 33]);
        *(v4u*)(WT + (size_t)(drow0 + n) * K + k0 + 8 * c) = o; }
    asm volatile("s_waitcnt lgkmcnt(0)" ::: "memory");
}

struct Args {
    const float* x; const float* norm_pre; const float* norm_post; const float* wg; const float* wu; const float* wd;
    const float* a_in; const float* a_out; const float* b_in; const float* b_out; const float* b_lambda; const float* b_subln;
    const float* c_in; const float* c_bin; const float* c_out; const float* c_sinks;
    float* out; unsigned char* ws;
};

__device__ __forceinline__ void rowpass(const float* F, const float* stats, const float* xin, float* xout, const float* gpost, float coef, const float* gpre, bf16* hout, int gw, int NGW, int lane) {
    for (int m = gw; m < M; m += NGW) {
        const f32x4* fr = (const f32x4*)(F + (size_t)m * D) + lane; const f32x4* xr = (const f32x4*)(xin + (size_t)m * D) + lane;
        float st = (lane < 16) ? stats[(size_t)m * 16 + lane] : 0.f;
        f32x4 f[4], x[4];
#pragma unroll
        for (int j = 0; j < 4; ++j) { f[j] = fr[64 * j]; x[j] = xr[64 * j]; }
        const float rstd = coef * __builtin_amdgcn_rsqf(wave_sum(st) * (1.f / D) + RMS_EPS);
        float s2 = 0.f;
#pragma unroll
        for (int j = 0; j < 4; ++j) { const f32x4 g = *((const f32x4*)gpost + lane + 64 * j); x[j] = x[j] + f[j] * g * rstd; s2 += (x[j].x * x[j].x + x[j].y * x[j].y) + (x[j].z * x[j].z + x[j].w * x[j].w);
            *((f32x4*)(xout + (size_t)m * D) + lane + 64 * j) = x[j]; }
        if (gpre) {
            const float r2 = __builtin_amdgcn_rsqf(wave_sum(s2) * (1.f / D) + RMS_EPS);
            v2u* o8 = (v2u*)(hout + (size_t)m * D) + lane;
#pragma unroll
            for (int j = 0; j < 4; ++j) { const f32x4 g = *((const f32x4*)gpre + lane + 64 * j); const f32x4 y = x[j] * g * r2; v2u w; w.x = pk2(y.x, y.y); w.y = pk2(y.z, y.w); o8[64 * j] = w; }
        }
    }
}

__device__ __forceinline__ float alibi_slope(int h, int nheads) { return exp2f(-8.0f * (float)(h + 1) / (float)nheads); }

__device__ __forceinline__ void prologue_phase(const Args& a, LAS unsigned char* lds, int gw, int NGW, int wave, int lane) {
    bf16* Wt = (bf16*)(a.ws + WS_W); bf16* Hb = (bf16*)(a.ws + WS_H);
    LAS float* scr = (LAS float*)(lds + wave * 16384);
    constexpr int I_FFN = 1408, N_FFN = 24 * I_FFN, I_AIN = 16 * 288, I_SQ = 512, I_BIN = 16 * 96, I_CIN = 16 * 40;
    constexpr int NITEMS = N_FFN + 2 * I_AIN + 2 * I_SQ + I_BIN + I_SQ + I_CIN + I_SQ;
    for (int it = gw; it < NITEMS; it += NGW) {
        int r = it; const float* src; bf16* dst; int K = D, N = D, mode = 0;
        if (r < N_FFN) { const int mi = r / I_FFN, f = mi / 3, kind = mi % 3; r -= mi * I_FFN;
            if (kind == 0) { src = a.wg + (size_t)f * D * DFF; dst = Wt + f * W_FFN; N = DFF; mode = 1; }
            else if (kind == 1) { src = a.wu + (size_t)f * D * DFF; dst = Wt + f * W_FFN; N = DFF; mode = 2; }
            else { src = a.wd + (size_t)f * DFF * D; dst = Wt + f * W_FFN + W_GU; K = DFF; }
        } else { r -= N_FFN;
            if (r < 2 * I_AIN) { const int j = r / I_AIN; r -= j * I_AIN; src = a.a_in + (size_t)j * D * 9216; dst = Wt + WO_AIN + j * W_AIN; N = 9216; }
            else { r -= 2 * I_AIN;
                if (r < 2 * I_SQ) { const int j = r / I_SQ; r -= j * I_SQ; src = a.a_out + (size_t)j * D * D; dst = Wt + WO_AOUT + j * W_SQ; }
                else { r -= 2 * I_SQ;
                    if (r < I_BIN) { src = a.b_in; dst = Wt + WO_BIN; N = 3072; }
                    else { r -= I_BIN;
                        if (r < I_SQ) { src = a.b_out; dst = Wt + WO_BOUT; }
                        else { r -= I_SQ;
                            if (r < I_CIN) { src = a.c_in; dst = Wt + WO_CIN; N = 1280; }
                            else { r -= I_CIN; src = a.c_out; dst = Wt + WO_COUT; } } } } } }
        transpose_item(src, K, N, dst, scr, r, lane, mode);
    }
    for (int m = gw; m < M; m += NGW) {
        const f32x4* xr = (const f32x4*)(a.x + (size_t)m * D) + lane; f32x4 x[4]; float s2 = 0.f;
#pragma unroll
        for (int j = 0; j < 4; ++j) { x[j] = xr[64 * j]; s2 += (x[j].x * x[j].x + x[j].y * x[j].y) + (x[j].z * x[j].z + x[j].w * x[j].w); }
        const float r2 = __builtin_amdgcn_rsqf(wave_sum(s2) * (1.f / D) + RMS_EPS);
        v2u* o8 = (v2u*)(Hb + (size_t)m * D) + lane;
#pragma unroll
        for (int j = 0; j < 4; ++j) { const f32x4 g = *((const f32x4*)a.norm_pre + lane + 64 * j); const f32x4 y = x[j] * g * r2; v2u w; w.x = pk2(y.x, y.y); w.y = pk2(y.z, y.w); o8[64 * j] = w; }
    }
}

__device__ __forceinline__ void attn_a_phase(const Args& a, LAS unsigned char* lds, int gi, int bid, int G, int wave, int lane) {
    const bf16* BIG = (const bf16*)(a.ws + WS_BIG); float* Fb = (float*)(a.ws + WS_F); bf16* Ob = (bf16*)(a.ws + WS_O); float* lse_run = (float*)(a.ws + WS_LSE);
    const int dil = (gi == 0) ? 1 : (gi == 1) ? 4 : 16; const int nsub = SEQ / dil, nqb = nsub / 256;
    for (int u = bid; u < 1024; u += G) {
        const int qb = u % nqb; int t = u / nqb; const int cls = t % dil; t /= dil; const int h = t & 15, b = t >> 4;
        const bf16* base = BIG + ((size_t)b * SEQ + cls) * 3072 + h * 64;
        const int n0 = qb * 256; const int kt_lo = (n0 >= 128) ? (n0 / 64 - 2) : 0, kt_hi = n0 / 64 + 4;
        const float slope2 = alibi_slope(h, 16) * (float)dil * LOG2E;
        att::f32x16 o[2]; float mrun = -1e30f, lrun = 0.f;
        att::core<64>(lds, base, base + 1024, base + 2048, (long)dil * 3072, n0, kt_lo, kt_hi, 128, slope2, o, mrun, lrun);
        const int l32 = lane & 31, hi = lane >> 5;
        lrun += __shfl_xor(lrun, 32);
        const float inv = 1.f / lrun; float lse = mrun + __log2f(lrun);
        const size_t tok = (size_t)b * SEQ + (size_t)(n0 + wave * 32 + l32) * dil + cls;
        float w_old = 0.f, w_new = 1.f;
        if (gi > 0) { const float lo = lse_run[tok * 16 + h]; const float mm = fmaxf(lo, lse); const float e0 = __builtin_amdgcn_exp2f(lo - mm), e1 = __builtin_amdgcn_exp2f(lse - mm);
            const float rs = 1.f / (e0 + e1); w_old = e0 * rs; w_new = e1 * rs; lse = mm + __log2f(e0 + e1); }
        if (gi < 2 && hi == 0) lse_run[tok * 16 + h] = lse;
        w_new *= inv;
#pragma unroll
        for (int d0 = 0; d0 < 2; ++d0)
#pragma unroll
            for (int gq = 0; gq < 4; ++gq) {
                const int d = d0 * 32 + 8 * gq + 4 * hi;
                f32x4 v = {o[d0][4 * gq] * w_new, o[d0][4 * gq + 1] * w_new, o[d0][4 * gq + 2] * w_new, o[d0][4 * gq + 3] * w_new};
                float* fp = Fb + tok * D + h * 64 + d;
                if (gi > 0) { const f32x4 old = *(const f32x4*)fp; v = v + old * w_old; }
                if (gi < 2) *(f32x4*)fp = v;
                else { v2u w; w.x = pk2(v.x, v.y); w.y = pk2(v.z, v.w); *(v2u*)(Ob + tok * D + h * 64 + d) = w; }
            }
    }
}

__device__ __forceinline__ void attn_b_phase(const Args& a, LAS unsigned char* lds, int layer, int bid, int G, int wave, int lane) {
    const bf16* BIG = (const bf16*)(a.ws + WS_BIG); float* Fb = (float*)(a.ws + WS_F); bf16* Ob = (bf16*)(a.ws + WS_O);
    const int jm = layer / 3;
    const float lambda_init = 0.8f - 0.6f * expf(-0.3f * (float)layer);
    const float* lam = a.b_lambda + (size_t)jm * 256;
    const float d1 = wave_sum(lam[lane] * lam[64 + lane]), d2 = wave_sum(lam[128 + lane] * lam[192 + lane]);
    const float lam_full = expf(d1) - expf(d2) + lambda_init;
    const float* subln = a.b_subln + (size_t)jm * 128;
    const int l32 = lane & 31, hi = lane >> 5;
    for (int u2 = bid; u2 < 1024; u2 += G) {
        const int u = u2 & 255, ps = u2 >> 8; const int c = ps & 1;
        const int s = u & 15, h = (u >> 4) & 7, b = u >> 7;
        const int qb = (ps >> 1) ? 31 - s : s; const int n0 = qb * 256;
        const size_t tok = (size_t)b * SEQ + n0 + wave * 32 + l32;
        const int hh = 2 * h + c;
        const bf16* base = BIG + (size_t)b * SEQ * 3072;
        const float slope2 = alibi_slope(h, 8) * LOG2E;
        att::f32x16 o[4]; float mrun = -1e30f, lrun = 0.f;
        att::core<128>(lds, base + hh * 64, base + 1024 + hh * 64, base + 2048 + h * 128, 3072L, n0, 0, n0 / 64 + 4, 1 << 30, slope2, o, mrun, lrun);
        lrun += __shfl_xor(lrun, 32);
        const float inv = 1.f / lrun;
        if (c == 0) {
#pragma unroll
            for (int d0 = 0; d0 < 4; ++d0)
#pragma unroll
                for (int gq = 0; gq < 4; ++gq) { const int d = d0 * 32 + 8 * gq + 4 * hi;
                    *(f32x4*)(Fb + tok * D + h * 128 + d) = (f32x4){o[d0][4 * gq] * inv, o[d0][4 * gq + 1] * inv, o[d0][4 * gq + 2] * inv, o[d0][4 * gq + 3] * inv}; }
        } else {
            const float sc2 = -lam_full * inv; float ss = 0.f;
#pragma unroll
            for (int d0 = 0; d0 < 4; ++d0)
#pragma unroll
                for (int gq = 0; gq < 4; ++gq) { const int d = d0 * 32 + 8 * gq + 4 * hi; const f32x4 o1 = *(const f32x4*)(Fb + tok * D + h * 128 + d);
#pragma unroll
                    for (int j = 0; j < 4; ++j) { const float df = o1[j] + sc2 * o[d0][4 * gq + j]; o[d0][4 * gq + j] = df; ss += df * df; } }
            ss += __shfl_xor(ss, 32);
            const float rs = __builtin_amdgcn_rsqf(ss * (1.f / 128.f) + RMS_EPS) * (1.f - lambda_init);
#pragma unroll
            for (int d0 = 0; d0 < 4; ++d0)
#pragma unroll
                for (int gq = 0; gq < 4; ++gq) { const int d = d0 * 32 + 8 * gq + 4 * hi; const f32x4 gs = *(const f32x4*)(subln + d);
                    v2u w; w.x = pk2(o[d0][4 * gq] * rs * gs.x, o[d0][4 * gq + 1] * rs * gs.y); w.y = pk2(o[d0][4 * gq + 2] * rs * gs.z, o[d0][4 * gq + 3] * rs * gs.w);
                    *(v2u*)(Ob + tok * D + h * 128 + d) = w; }
        }
    }
}

__device__ __forceinline__ void attn_c_phase(const Args& a, LAS unsigned char* lds, int jm, int bid, int G, int wave, int lane) {
    const bf16* BIG = (const bf16*)(a.ws + WS_BIG); bf16* Ob = (bf16*)(a.ws + WS_O);
    for (int u = bid; u < 1024; u += G) {
        const int qb = u & 31, h = (u >> 5) & 15, b = u >> 9; const int kvh = h >> 3;
        const bf16* base = BIG + (size_t)b * SEQ * 1280;
        const int n0 = qb * 256; const int kt_lo = (n0 >= 128) ? (n0 / 64 - 2) : 0, kt_hi = n0 / 64 + 4;
        const float slope2 = alibi_slope(h, 16) * LOG2E;
        const int l32 = lane & 31, hi = lane >> 5;
        att::f32x16 o[2]; float mrun = a.c_sinks[jm * 16 + h] * LOG2E, lrun = (hi == 0) ? 1.f : 0.f;
        att::core<64>(lds, base + h * 64, base + 1024 + kvh * 64, base + 1152 + kvh * 64, 1280L, n0, kt_lo, kt_hi, 127, slope2, o, mrun, lrun);
        lrun += __shfl_xor(lrun, 32);
        const float inv = 1.f / lrun;
        const size_t tok = (size_t)b * SEQ + n0 + wave * 32 + l32;
#pragma unroll
        for (int d0 = 0; d0 < 2; ++d0)
#pragma unroll
            for (int gq = 0; gq < 4; ++gq) { const int d = d0 * 32 + 8 * gq + 4 * hi;
                v2u w; w.x = pk2(o[d0][4 * gq] * inv, o[d0][4 * gq + 1] * inv); w.y = pk2(o[d0][4 * gq + 2] * inv, o[d0][4 * gq + 3] * inv);
                *(v2u*)(Ob + tok * D + h * 64 + d) = w; }
    }
}

constexpr int STEPS = 14;
__global__ void __launch_bounds__(NWAVES * 64, 2) mega_fwd(Args a) {
    extern __shared__ __attribute__((aligned(16))) unsigned char lds_raw[];
    LAS unsigned char* lds = (LAS unsigned char*)lds_raw;
    cg::grid_group grid = cg::this_grid();
    prologue_phase(a, lds, blockIdx.x * NWAVES + __builtin_amdgcn_readfirstlane(threadIdx.x >> 6), gridDim.x * NWAVES, __builtin_amdgcn_readfirstlane(threadIdx.x >> 6), threadIdx.x & 63);
    grid.sync();
#pragma unroll 1
    for (int ph = 0; ph < DEPTH * STEPS; ++ph) {
        const int layer = ph / STEPS, st = ph % STEPS; const int kind = layer % 3, jm = layer / 3;
        if (kind != 0 && st >= 5 && st <= 8) continue;
        const int G = gridDim.x, bid = blockIdx.x; const int tid_ = opaque_tid(); const int lane = tid_ & 63; const int wave = __builtin_amdgcn_readfirstlane(tid_ >> 6);
        unsigned char* ws = a.ws;
        bf16* Wt = (bf16*)(ws + WS_W);
        if (st == 0 || st == 11) {
            const int f = layer * 2 + (st == 11);
            pg8::Gemm g{(const bf16*)(ws + WS_H), Wt + f * W_FFN, M, 2 * DFF, D}; pg8::StaticOrder S; S.init(M, 2 * DFF, G, bid);
            pg8::EpiSwiGLU E{(bf16*)(ws + WS_BIG), DFF};
            pg8::gemm_phase<pg8::EpiSwiGLU, pg8::StaticOrder, true, true>(lds, g, S, E);
        } else if (st == 1 || st == 12 || st == 9) {
            pg8::Gemm g; g.M = M; g.N = D;
            if (st == 9) { g.A = (const bf16*)(ws + WS_O); g.K = D; g.Bt = (kind == 0) ? Wt + WO_AOUT + jm * W_SQ : (kind == 1) ? Wt + WO_BOUT : Wt + WO_COUT; }
            else { const int f = layer * 2 + (st == 12); g.A = (const bf16*)(ws + WS_BIG); g.K = DFF; g.Bt = Wt + f * W_FFN + W_GU; }
            pg8::StaticOrder S; S.init(M, D, G, bid);
            pg8::EpiF32Stats E{(float*)(ws + WS_F), D, (float*)(ws + WS_STATS)};
            pg8::gemm_phase<pg8::EpiF32Stats, pg8::StaticOrder, true, true>(lds, g, S, E);
        } else if (st == 3 || st == 5 || st == 7) {
            pg8::Gemm g; g.A = (const bf16*)(ws + WS_H); g.M = M; g.K = D; const float* bias = nullptr;
            if (kind == 0) { g.N = 3072; g.Bt = Wt + WO_AIN + jm * W_AIN + (size_t)((st - 3) >> 1) * 3072 * D; }
            else if (kind == 1) { g.N = 3072; g.Bt = Wt + WO_BIN; }
            else { g.N = 1280; g.Bt = Wt + WO_CIN; bias = a.c_bin + (size_t)jm * 1280; }
            pg8::StaticOrder S; S.init(M, g.N, G, bid);
            pg8::EpiProj E{(bf16*)(ws + WS_BIG), g.N, bias, QSCALE};
            pg8::gemm_phase<pg8::EpiProj, pg8::StaticOrder, true, true>(lds, g, S, E);
        } else if (st == 4 || st == 6 || st == 8) {
            if (kind == 0) attn_a_phase(a, lds, (st - 4) >> 1, bid, G, wave, lane);
            else if (kind == 1) attn_b_phase(a, lds, layer, bid, G, wave, lane);
            else attn_c_phase(a, lds, jm, bid, G, wave, lane);
        } else {
            const int gw = bid * NWAVES + wave, NGW = G * NWAVES;
            const int pi = (st == 2) ? 0 : (st == 10) ? 1 : 2;
            const float* gpre = (pi < 2) ? a.norm_pre + (size_t)(layer * 3 + pi + 1) * D : (layer + 1 < DEPTH ? a.norm_pre + (size_t)((layer + 1) * 3) * D : nullptr);
            const float* xin = (ph == 2) ? a.x : a.out;
            rowpass((const float*)(ws + WS_F), (const float*)(ws + WS_STATS), xin, a.out, a.norm_post + (size_t)(layer * 3 + pi) * D, (pi == 1) ? 1.0f : 0.5f, gpre, (bf16*)(ws + WS_H), gw, NGW, lane);
        }
        if (ph != DEPTH * STEPS - 1) grid.sync();
    }
}

extern "C" void kernel_launch(void* const* d_in, const int* in_sizes, int n_in, void* d_out, int out_size, void* d_ws, size_t ws_size, hipStream_t stream) {
    static int grid_blocks = 0;
    if (grid_blocks == 0) {
        if (n_in != 16 || in_sizes[0] != M * D || out_size != M * D || ws_size < WS_END) { fprintf(stderr, "kernel_launch: unexpected shapes / workspace (%d inputs, ws %zu)\n", n_in, ws_size); grid_blocks = -1; return; }
        int dev = 0, cus = 0, per_cu = 0;
        hipGetDevice(&dev);
        hipDeviceGetAttribute(&cus, hipDeviceAttributeMultiprocessorCount, dev);
        if (hipFuncSetAttribute((const void*)mega_fwd, hipFuncAttributeMaxDynamicSharedMemorySize, LDS_BYTES) != hipSuccess) { fprintf(stderr, "hipFuncSetAttribute failed\n"); grid_blocks = -1; return; }
        if (hipOccupancyMaxActiveBlocksPerMultiprocessor(&per_cu, (const void*)mega_fwd, NWAVES * 64, LDS_BYTES) != hipSuccess || per_cu < 1) { fprintf(stderr, "occupancy query failed (%d)\n", per_cu); per_cu = 1; }
        (void)hipGetLastError();
        grid_blocks = cus * per_cu;
    }
    if (grid_blocks < 0) return;
    Args a{};
    a.x = (const float*)d_in[0]; a.norm_pre = (const float*)d_in[1]; a.norm_post = (const float*)d_in[2]; a.wg = (const float*)d_in[3]; a.wu = (const float*)d_in[4]; a.wd = (const float*)d_in[5];
    a.a_in = (const float*)d_in[6]; a.a_out = (const float*)d_in[7]; a.b_in = (const float*)d_in[8]; a.b_out = (const float*)d_in[9]; a.b_lambda = (const float*)d_in[10]; a.b_subln = (const float*)d_in[11];
    a.c_in = (const float*)d_in[12]; a.c_bin = (const float*)d_in[13]; a.c_out = (const float*)d_in[14]; a.c_sinks = (const float*)d_in[15];
    a.out = (float*)d_out; a.ws = (unsigned char*)d_ws;
    void* args[] = {&a};
    hipError_t e = hipLaunchCooperativeKernel((const void*)mega_fwd, dim3(grid_blocks), dim3(NWAVES * 64), args, LDS_BYTES, stream);
    if (e != hipSuccess) fprintf(stderr, "cooperative launch failed: %s (grid %d)\n", hipGetErrorString(e), grid_blocks);
}
```

```cpp
#include <hip/hip_runtime.h>
#include <hip/hip_cooperative_groups.h>
#include <cstdio>
#include <cstdint>
#include <cmath>
__device__ __forceinline__ int opaque_tid() { int t = threadIdx.x; asm volatile("" : "+v"(t)); return t; }
namespace pg8 {
#define PG8_LAS __attribute__((address_space(3)))
typedef unsigned short bf16_t;
typedef short bf16x8 __attribute__((ext_vector_type(8)));
typedef float f32x4 __attribute__((ext_vector_type(4)));
typedef unsigned u32x4 __attribute__((ext_vector_type(4)));
constexpr int BM = 256, BK = 64, HALF = 128, HTB = HALF * BK * 2  , STAGE_BYTES = 8 * HTB, NXCD = 8, WGM = 8;

__host__ __device__ __forceinline__ int lds_byte(int r, int c) { const int st = (r >> 4) * 2 + (c >> 5), rr = r & 15, cc = c & 31, ob = rr * 64 + cc * 2; return st * 1024 + (ob ^ (((ob >> 9) & 1) << 5)); }
__host__ __device__ __forceinline__ void stage_rc(int b, int& R, int& C) { const int st = b / 1024, sb = b % 1024, swz = sb ^ (((sb >> 9) & 1) << 5); R = (st >> 1) * 16 + swz / 64; C = (st & 1) * 32 + (swz % 64) / 2; }
__host__ __device__ __forceinline__ int perm32(int rho) { const int n = rho >> 4, i = rho & 15; return 8 * (i >> 2) + 4 * n + (i & 3); }

struct Unit { int pm, pn; };
struct Gemm { const bf16_t* A; const bf16_t* Bt; int M, N, K; };

struct StaticOrder {
    int nM, nN, nwg, G, c;
    __host__ __device__ void init(int M, int N, int G_, int c_) { nM = M / BM; nN = N / BM; nwg = nM * nN; G = G_; c = c_; }
    __host__ __device__ bool next(int i, Unit& u) const {
        const long L = (long)i * G + c; if (L >= nwg) return false;
        int wgid = (int)L; { const int q = nwg / NXCD, r = nwg % NXCD, xcd = wgid % NXCD, off = wgid / NXCD; wgid = (xcd < r ? xcd * (q + 1) : r * (q + 1) + (xcd - r) * q) + off; }
        const int nig = WGM * nN, gid = wgid / nig, fm = gid * WGM, gsz = (nM - fm) < WGM ? (nM - fm) : WGM;
        u.pm = fm + ((wgid % nig) % gsz); u.pn = (wgid % nig) / gsz; return true;
    }
    __device__ __forceinline__ void a_ready(const Unit&) const {}
    __device__ __forceinline__ void done(const Unit&) const {}
};


typedef float f32x2 __attribute__((ext_vector_type(2)));
typedef __bf16 bf16x2_t __attribute__((ext_vector_type(2)));
__device__ __forceinline__ unsigned cvt_pk_bf16(float lo, float hi) { f32x2 v = {lo, hi}; bf16x2_t b = __builtin_convertvector(v, bf16x2_t); return __builtin_bit_cast(unsigned, b); }

struct EpiProj {
    static constexpr bool PERM = true, AFTER_DRAIN = false;
    bf16_t* O; int ldc; const float* bias; float qscale;
    __device__ __forceinline__ void operator()(const f32x4 (&acc)[2][2][4][2], const Unit& u, int wr, int wc, int fr, int fq) const {
        const int row0 = u.pm * BM + wr * 64 + fr; const int colt = u.pn * BM;
        const float sc = (((colt >> 10) % 3) == 0) ? qscale : 1.f;
        const int col0 = colt + wc * 32 + 8 * fq;
        f32x4 bv[2][2];
#pragma unroll
        for (int bj = 0; bj < 2; ++bj)
#pragma unroll
            for (int n = 0; n < 2; ++n) bv[bj][n] = bias ? *(const f32x4*)(bias + col0 + bj * HALF + 4 * n) : (f32x4){0.f, 0.f, 0.f, 0.f};
#pragma unroll
        for (int ai = 0; ai < 2; ++ai)
#pragma unroll
            for (int m = 0; m < 4; ++m) { bf16_t* rowp = O + (size_t)(row0 + ai * HALF + m * 16) * ldc + col0;
#pragma unroll
                for (int bj = 0; bj < 2; ++bj) { f32x4 v0 = (acc[ai][bj][m][0] + bv[bj][0]) * sc, v1 = (acc[ai][bj][m][1] + bv[bj][1]) * sc;
                    u32x4 w; w.x = cvt_pk_bf16(v0[0], v0[1]); w.y = cvt_pk_bf16(v0[2], v0[3]); w.z = cvt_pk_bf16(v1[0], v1[1]); w.w = cvt_pk_bf16(v1[2], v1[3]);
                    *(u32x4*)(rowp + bj * HALF) = w; } }
    }
};

struct EpiSwiGLU {
    static constexpr bool PERM = true, AFTER_DRAIN = false;
    bf16_t* O; int ldc;
    __device__ __forceinline__ void operator()(const f32x4 (&acc)[2][2][4][2], const Unit& u, int wr, int wc, int fr, int fq) const {
        const int row0 = u.pm * BM + wr * 64 + fr; const int col0 = u.pn * HALF + wc * 32 + 8 * fq;
#pragma unroll
        for (int ai = 0; ai < 2; ++ai)
#pragma unroll
            for (int m = 0; m < 4; ++m) { bf16_t* rowp = O + (size_t)(row0 + ai * HALF + m * 16) * ldc + col0;
                float r[8];
#pragma unroll
                for (int n = 0; n < 2; ++n)
#pragma unroll
                    for (int j = 0; j < 4; ++j) { const float g = acc[ai][0][m][n][j], up = acc[ai][1][m][n][j];
                        const float e = __builtin_amdgcn_exp2f(g * -1.4426950408889634f);
                        r[n * 4 + j] = g * __builtin_amdgcn_rcpf(1.f + e) * up; }
                u32x4 w; w.x = cvt_pk_bf16(r[0], r[1]); w.y = cvt_pk_bf16(r[2], r[3]); w.z = cvt_pk_bf16(r[4], r[5]); w.w = cvt_pk_bf16(r[6], r[7]);
                *(u32x4*)rowp = w; }
    }
};

struct EpiF32Stats {
    static constexpr bool PERM = false, AFTER_DRAIN = false;
    float* F; int ldc; float* stats;
    __device__ __forceinline__ void operator()(const f32x4 (&acc)[2][2][4][2], const Unit& u, int wr, int wc, int fr, int fq) const {
        const int row0 = u.pm * BM + wr * 64 + fr; const int col0 = u.pn * BM + wc * 32 + 4 * fq;
#pragma unroll
        for (int ai = 0; ai < 2; ++ai)
#pragma unroll
            for (int m = 0; m < 4; ++m) { const int row = row0 + ai * HALF + m * 16; float* rowp = F + (size_t)row * ldc + col0; float s = 0.f;
#pragma unroll
                for (int bj = 0; bj < 2; ++bj)
#pragma unroll
                    for (int n = 0; n < 2; ++n) { const f32x4 v = acc[ai][bj][m][n]; s += (v[0] * v[0] + v[1] * v[1]) + (v[2] * v[2] + v[3] * v[3]); *(f32x4*)(rowp + bj * HALF + n * 16) = v; }
                s += __shfl_xor(s, 16); s += __shfl_xor(s, 32);
                if (fq == 0) stats[(size_t)row * 16 + u.pn * 4 + wc] = s; }
    }
};
template <class Epi, class Sched, bool ALIGN_EPI = false, bool SP2 = false>
__device__ __forceinline__ void gemm_phase(PG8_LAS unsigned char* lds, const Gemm g, const Sched& S, const Epi& E) {
    const int tid = opaque_tid(), wid = __builtin_amdgcn_readfirstlane(tid >> 6), lane = tid & 63, wr = wid >> 2, wc = wid & 3, fr = lane & 15, fq = lane >> 4;
    const int K = g.K, nt = K / BK;
    unsigned voffA[2], voffB[2];
#pragma unroll
    for (int i = 0; i < 2; ++i) { int R, C; stage_rc(tid * 16 + i * 8192, R, C); const int Rb = Epi::PERM ? ((R & ~31) + perm32(R & 31)) : R;
        voffA[i] = (unsigned)(R * K + C) * 2u; voffB[i] = (unsigned)(Rb * K + C) * 2u; }
    const size_t kstep = (size_t)(BK * 2);
    const size_t hstep = (size_t)HALF * K * 2;
    const size_t tstep = 2 * hstep;
    const unsigned ldsw = (unsigned)wid * 1024u;
    const int aoff = lds_byte(wr * 64 + fr, fq * 8), boff = lds_byte(wc * 32 + fr, fq * 8);
#define PG8_SA(b, h) (((b) * 2 + (h)) * HTB)
#define PG8_SB(b, h) ((4 + (b) * 2 + (h)) * HTB)
#define PG8_STAGE(bufoff, gbase, voff) do { _Pragma("unroll") for (int _i = 0; _i < 2; ++_i) \
        __builtin_amdgcn_global_load_lds((const unsigned*)((const char*)(gbase) + (voff)[_i]), (PG8_LAS unsigned*)(lds + (bufoff) + ldsw + _i * 8192), 16, 0, 0); } while (0)
#define PG8_LDA(dst, b, h) do { _Pragma("unroll") for (int m = 0; m < 4; ++m) _Pragma("unroll") for (int k = 0; k < 2; ++k) dst[m][k] = *(const PG8_LAS bf16x8*)(lds + PG8_SA(b, h) + aoff + m * 2048 + k * 1024); } while (0)
#define PG8_LDB(dst, b, h) do { _Pragma("unroll") for (int n = 0; n < 2; ++n) _Pragma("unroll") for (int k = 0; k < 2; ++k) dst[n][k] = *(const PG8_LAS bf16x8*)(lds + PG8_SB(b, h) + boff + n * 2048 + k * 1024); } while (0)
#define PG8_MMA(ai, bj, At, Bt) do { __builtin_amdgcn_s_setprio(1); _Pragma("unroll") for (int m = 0; m < 4; ++m) _Pragma("unroll") for (int n = 0; n < 2; ++n) _Pragma("unroll") for (int k = 0; k < 2; ++k) \
        acc[ai][bj][m][n] = __builtin_amdgcn_mfma_f32_16x16x32_bf16(Bt[n][k], At[m][k], acc[ai][bj][m][n], 0, 0, 0); __builtin_amdgcn_s_setprio(0); } while (0)
#define PG8_WAIT_V(n) asm volatile("s_waitcnt vmcnt(" #n ")" ::: "memory")
#define PG8_WAIT_L(n) asm volatile("s_waitcnt lgkmcnt(" #n ")" ::: "memory")
#define PG8_BAR __builtin_amdgcn_s_barrier()
#define PG8_SCHED __builtin_amdgcn_sched_barrier(0)
    Unit cur, nxt; int ui = 0;
    if (!S.next(0, cur)) return;
    f32x4 acc[2][2][4][2];
#pragma unroll
    for (int a = 0; a < 2; ++a)
#pragma unroll
        for (int b = 0; b < 2; ++b)
#pragma unroll
            for (int m = 0; m < 4; ++m)
#pragma unroll
                for (int n = 0; n < 2; ++n) acc[a][b][m][n] = (f32x4){0.f, 0.f, 0.f, 0.f};
    bf16x8 At[4][2], B0[2][2], B1[2][2];
    const char* cA = (const char*)g.A + (size_t)cur.pm * tstep; const char* cB = (const char*)g.Bt + (size_t)cur.pn * tstep;
    S.a_ready(cur);
    if constexpr (SP2) {
        PG8_STAGE(PG8_SB(0, 0), cB, voffB); PG8_STAGE(PG8_SB(0, 1), cB + hstep, voffB); PG8_STAGE(PG8_SA(0, 0), cA, voffA); PG8_STAGE(PG8_SA(0, 1), cA + hstep, voffA);
        if (wr == 1) PG8_BAR;
        PG8_WAIT_V(2); PG8_BAR;
        PG8_STAGE(PG8_SB(1, 0), cB + kstep, voffB); PG8_STAGE(PG8_SA(1, 0), cA + kstep, voffA); PG8_STAGE(PG8_SB(1, 1), cB + hstep + kstep, voffB);
        PG8_WAIT_V(6); PG8_BAR;
    } else {
        PG8_STAGE(PG8_SB(0, 0), cB, voffB); PG8_STAGE(PG8_SA(0, 0), cA, voffA); PG8_STAGE(PG8_SB(0, 1), cB + hstep, voffB); PG8_STAGE(PG8_SA(0, 1), cA + hstep, voffA);
        if (wr == 1) PG8_BAR;
        PG8_WAIT_V(4); PG8_BAR;
        PG8_STAGE(PG8_SB(1, 0), cB + kstep, voffB); PG8_STAGE(PG8_SA(1, 0), cA + kstep, voffA); PG8_STAGE(PG8_SB(1, 1), cB + hstep + kstep, voffB);
        PG8_WAIT_V(6); PG8_BAR;
    }
    for (;;) {
        const bool has_next = S.next(ui + 1, nxt);
        const char* nA = has_next ? (const char*)g.A + (size_t)nxt.pm * tstep : cA; const char* nB = has_next ? (const char*)g.Bt + (size_t)nxt.pn * tstep : cB;
        for (int t = 0; t < nt; t += 2) {
            const bool last = (t == nt - 2);
            const char* a1 = cA + (size_t)(t + 1) * kstep;
            const char* a2 = last ? nA : cA + (size_t)(t + 2) * kstep; const char* b2 = last ? nB : cB + (size_t)(t + 2) * kstep;
            const char* a3 = a2 + kstep; const char* b3 = b2 + kstep;
            if (last && has_next) S.a_ready(nxt);
            if constexpr (SP2) {
            PG8_LDB(B0, 0, 0); PG8_LDB(B1, 0, 1); PG8_SCHED; PG8_LDA(At, 0, 0); PG8_STAGE(PG8_SA(1, 1), a1 + hstep, voffA);
            PG8_WAIT_V(8); PG8_WAIT_L(0); PG8_BAR; PG8_MMA(0, 0, At, B0); PG8_MMA(0, 1, At, B1); PG8_BAR; PG8_SCHED;
            PG8_LDA(At, 0, 1); PG8_STAGE(PG8_SB(0, 0), b2, voffB); PG8_STAGE(PG8_SB(0, 1), b2 + hstep, voffB); PG8_STAGE(PG8_SA(0, 0), a2, voffA);
            PG8_WAIT_V(8); PG8_WAIT_L(0); PG8_BAR; PG8_MMA(1, 0, At, B0); PG8_MMA(1, 1, At, B1); PG8_BAR; PG8_SCHED;
            PG8_LDB(B0, 1, 0); PG8_LDB(B1, 1, 1); PG8_SCHED; PG8_LDA(At, 1, 0); PG8_STAGE(PG8_SA(0, 1), a2 + hstep, voffA);
            PG8_WAIT_V(8); PG8_WAIT_L(0); PG8_BAR; PG8_MMA(0, 0, At, B0); PG8_MMA(0, 1, At, B1); PG8_BAR; PG8_SCHED;
            PG8_LDA(At, 1, 1); PG8_STAGE(PG8_SB(1, 0), b3, voffB); PG8_STAGE(PG8_SB(1, 1), b3 + hstep, voffB); PG8_STAGE(PG8_SA(1, 0), a3, voffA);
            PG8_WAIT_V(8); PG8_WAIT_L(0); PG8_BAR; PG8_MMA(1, 0, At, B0); PG8_MMA(1, 1, At, B1); PG8_BAR; PG8_SCHED;
            } else {
            PG8_LDB(B0, 0, 0); PG8_SCHED; PG8_LDA(At, 0, 0); PG8_STAGE(PG8_SA(1, 1), a1 + hstep, voffA);
            PG8_WAIT_L(8); PG8_BAR; PG8_WAIT_L(0); PG8_MMA(0, 0, At, B0); PG8_BAR; PG8_SCHED;
            PG8_LDB(B1, 0, 1); PG8_STAGE(PG8_SB(0, 0), b2, voffB);
            PG8_BAR; PG8_WAIT_L(0); PG8_MMA(0, 1, At, B1); PG8_BAR;
            PG8_LDA(At, 0, 1); PG8_STAGE(PG8_SA(0, 0), a2, voffA);
            PG8_BAR; PG8_WAIT_L(0); PG8_MMA(1, 0, At, B0); PG8_BAR; PG8_SCHED;
            PG8_STAGE(PG8_SB(0, 1), b2 + hstep, voffB);
            PG8_WAIT_V(6); PG8_BAR; PG8_MMA(1, 1, At, B1); PG8_BAR;
            PG8_LDB(B0, 1, 0); PG8_SCHED; PG8_LDA(At, 1, 0); PG8_STAGE(PG8_SA(0, 1), a2 + hstep, voffA);
            PG8_WAIT_L(8); PG8_BAR; PG8_WAIT_L(0); PG8_MMA(0, 0, At, B0); PG8_BAR; PG8_SCHED;
            PG8_LDB(B1, 1, 1); PG8_STAGE(PG8_SB(1, 0), b3, voffB);
            PG8_BAR; PG8_WAIT_L(0); PG8_MMA(0, 1, At, B1); PG8_BAR;
            PG8_LDA(At, 1, 1); PG8_STAGE(PG8_SA(1, 0), a3, voffA);
            PG8_BAR; PG8_WAIT_L(0); PG8_MMA(1, 0, At, B0); PG8_BAR; PG8_SCHED;
            PG8_STAGE(PG8_SB(1, 1), b3 + hstep, voffB);
            PG8_WAIT_V(6); PG8_BAR; PG8_MMA(1, 1, At, B1); PG8_BAR;
            }
        }
        if constexpr (ALIGN_EPI) { if (wr == 0) PG8_BAR; }
        if constexpr (!Epi::AFTER_DRAIN) { E(acc, cur, wr, wc, fr, fq); S.done(cur); }
        if (!has_next) break;
#pragma unroll
        for (int a = 0; a < 2; ++a)
#pragma unroll
            for (int b = 0; b < 2; ++b)
#pragma unroll
                for (int m = 0; m < 4; ++m)
#pragma unroll
                    for (int n = 0; n < 2; ++n) acc[a][b][m][n] = (f32x4){0.f, 0.f, 0.f, 0.f};
        cur = nxt; cA = nA; cB = nB; ++ui;
        if constexpr (ALIGN_EPI) { if (wr == 1) PG8_BAR; }
    }
    PG8_WAIT_V(0);
    if constexpr (!ALIGN_EPI) { if (wr == 0) PG8_BAR; }
    PG8_BAR;
    if constexpr (Epi::AFTER_DRAIN) { E.fused(acc, cur, wr, wc, fr, fq, lds, wid, lane); S.done(cur); }
#undef PG8_SA
#undef PG8_SB
#undef PG8_STAGE
#undef PG8_LDA
#undef PG8_LDB
#undef PG8_MMA
#undef PG8_WAIT_V
#undef PG8_WAIT_L
#undef PG8_BAR
#undef PG8_SCHED
}
}

namespace att {
typedef unsigned short bf16_t;
typedef short bf16x8 __attribute__((ext_vector_type(8)));
typedef short s16x4 __attribute__((ext_vector_type(4)));
typedef float f32x16 __attribute__((ext_vector_type(16)));
typedef float f32x4 __attribute__((ext_vector_type(4)));
typedef unsigned u32x4 __attribute__((ext_vector_type(4)));
typedef unsigned u32x2 __attribute__((ext_vector_type(2)));
#define ATT_LAS __attribute__((address_space(3)))
constexpr int KROWB = 144;
constexpr int VROWB = 136;
constexpr int KBYTES = 64 * KROWB;
template <int DV> struct Geo { static constexpr int VBYTES = DV * VROWB, BUF = KBYTES + VBYTES; };
typedef __bf16 bf16x2_t __attribute__((ext_vector_type(2)));
typedef float f32x2 __attribute__((ext_vector_type(2)));
__device__ __forceinline__ unsigned pk2(float lo, float hi) { f32x2 v = {lo, hi}; bf16x2_t b = __builtin_convertvector(v, bf16x2_t); return __builtin_bit_cast(unsigned, b); }
__device__ __forceinline__ int crow(int r, int hi) { return (r & 3) + 8 * (r >> 2) + 4 * hi; }

template <int DV>
__device__ __forceinline__ void core(ATT_LAS unsigned char* lds, const bf16_t* __restrict__ qp, const bf16_t* __restrict__ kp, const bf16_t* __restrict__ vp, long stride,
                                     int n0, int kt_lo, int kt_hi, int max_dist, float slope2, f32x16 (&o)[DV / 32], float& m, float& l) {
    const int tid = opaque_tid(), lane = tid & 63, l32 = lane & 31, hi = lane >> 5; const int wid = __builtin_amdgcn_readfirstlane(tid >> 6);
    const int wq0 = n0 + wid * 32, qi = wq0 + l32;
    bf16x8 qf[4];
#pragma unroll
    for (int s = 0; s < 4; ++s) qf[s] = *(const bf16x8*)(qp + (long)qi * stride + s * 16 + hi * 8);
#pragma unroll
    for (int d0 = 0; d0 < DV / 32; ++d0)
#pragma unroll
        for (int r = 0; r < 16; ++r) o[d0][r] = 0.f;
    const int kkey = tid >> 3, kch = tid & 7;
    const bf16_t* kg = kp + (long)kkey * stride + kch * 8;
    const bf16_t* vg = vp + (long)lane * stride + wid * 8;
    const long tstep = 64 * stride;
    u32x4 kreg, vreg[DV / 64];
    kreg = *(const u32x4*)(kg + (long)kt_lo * tstep);
#pragma unroll
    for (int j = 0; j < DV / 64; ++j) vreg[j] = *(const u32x4*)(vg + (long)kt_lo * tstep + j * 64);
    int cur = 0;
    for (int kt = kt_lo; kt < kt_hi; ++kt) {
        ATT_LAS unsigned char* Kb = lds + cur * Geo<DV>::BUF; ATT_LAS unsigned char* Vb = Kb + KBYTES;
        *(ATT_LAS u32x4*)(Kb + kkey * KROWB + kch * 16) = kreg;
#pragma unroll
        for (int j = 0; j < DV / 64; ++j) {
            const int dbase = (wid + 8 * j) * 8;
#pragma unroll
            for (int e = 0; e < 4; ++e) {
                const unsigned w = vreg[j][e];
                *(ATT_LAS unsigned short*)(Vb + (dbase + 2 * e) * VROWB + lane * 2) = (unsigned short)(w & 0xffffu);
                *(ATT_LAS unsigned short*)(Vb + (dbase + 2 * e + 1) * VROWB + lane * 2) = (unsigned short)(w >> 16);
            }
        }
        __syncthreads();
        if (kt + 1 < kt_hi) {
            kreg = *(const u32x4*)(kg + (long)(kt + 1) * tstep);
#pragma unroll
            for (int j = 0; j < DV / 64; ++j) vreg[j] = *(const u32x4*)(vg + (long)(kt + 1) * tstep + j * 64);
        }
        const int k0 = kt * 64;
        const bool relevant = (k0 <= wq0 + 31) && (k0 + 63 >= wq0 - max_dist);
        if (relevant) {
            f32x16 s0, s1;
#pragma unroll
            for (int r = 0; r < 16; ++r) { s0[r] = 0.f; s1[r] = 0.f; }
#pragma unroll
            for (int s = 0; s < 4; ++s) {
                const bf16x8 ka = *(const ATT_LAS bf16x8*)(Kb + l32 * KROWB + s * 32 + hi * 16);
                const bf16x8 kb = *(const ATT_LAS bf16x8*)(Kb + (32 + l32) * KROWB + s * 32 + hi * 16);
                s0 = __builtin_amdgcn_mfma_f32_32x32x16_bf16(ka, qf[s], s0, 0, 0, 0);
                s1 = __builtin_amdgcn_mfma_f32_32x32x16_bf16(kb, qf[s], s1, 0, 0, 0);
            }
            const int rel0 = k0 + 4 * hi - qi;
            const float relf = (float)rel0;
#pragma unroll
            for (int r = 0; r < 16; ++r) {
                const float c = (float)((r & 3) + 8 * (r >> 2));
                s0[r] = s0[r] + slope2 * (relf + c);
                s1[r] = s1[r] + slope2 * (relf + c + 32.f);
            }
            const bool need_mask = (k0 + 63 > wq0) || (k0 < wq0 + 31 - max_dist);
            if (need_mask) {
#pragma unroll
                for (int r = 0; r < 16; ++r) {
                    const int rel = rel0 + (r & 3) + 8 * (r >> 2);
                    if (rel > 0 || rel < -max_dist) s0[r] = -INFINITY;
                    if (rel + 32 > 0 || rel + 32 < -max_dist) s1[r] = -INFINITY;
                }
            }
            float mx = fmaxf(s0[0], s1[0]);
#pragma unroll
            for (int r = 1; r < 16; ++r) mx = fmaxf(mx, fmaxf(s0[r], s1[r]));
            mx = fmaxf(mx, __shfl_xor(mx, 32));
            const float mnew = fmaxf(m, mx);
            const float alpha = __builtin_amdgcn_exp2f(m - mnew);
            m = mnew;
            float ps = 0.f;
#pragma unroll
            for (int r = 0; r < 16; ++r) { s0[r] = __builtin_amdgcn_exp2f(s0[r] - mnew); s1[r] = __builtin_amdgcn_exp2f(s1[r] - mnew); ps += s0[r] + s1[r]; }
            l = l * alpha + ps;
#pragma unroll
            for (int d0 = 0; d0 < DV / 32; ++d0)
#pragma unroll
                for (int r = 0; r < 16; ++r) o[d0][r] *= alpha;
            u32x4 pw[4];
#pragma unroll
            for (int e = 0; e < 4; ++e) {
                pw[0][e] = pk2(s0[2 * e], s0[2 * e + 1]); pw[1][e] = pk2(s0[8 + 2 * e], s0[8 + 2 * e + 1]);
                pw[2][e] = pk2(s1[2 * e], s1[2 * e + 1]); pw[3][e] = pk2(s1[8 + 2 * e], s1[8 + 2 * e + 1]);
            }
#pragma unroll
            for (int ks = 0; ks < 4; ++ks) {
                const bf16x8 pf = __builtin_bit_cast(bf16x8, pw[ks]);
#pragma unroll
                for (int d0 = 0; d0 < DV / 32; ++d0) {
                    const ATT_LAS unsigned char* vr = Vb + (d0 * 32 + l32) * VROWB + (ks * 16 + 4 * hi) * 2;
                    const s16x4 lo = *(const ATT_LAS s16x4*)(vr), hh = *(const ATT_LAS s16x4*)(vr + 16);
                    const bf16x8 vf = (bf16x8){lo[0], lo[1], lo[2], lo[3], hh[0], hh[1], hh[2], hh[3]};
                    o[d0] = __builtin_amdgcn_mfma_f32_32x32x16_bf16(vf, pf, o[d0], 0, 0, 0);
                }
            }
        }
        cur ^= 1;
    }
    __syncthreads();
}
}

namespace cg = cooperative_groups;
typedef unsigned short bf16;
typedef float f32x4 __attribute__((ext_vector_type(4)));
typedef unsigned v4u __attribute__((ext_vector_type(4)));
typedef unsigned v2u __attribute__((ext_vector_type(2)));
#define LAS __attribute__((address_space(3)))
constexpr int NWAVES = 8;
constexpr int BATCH = 2, SEQ = 8192, D = 1024, DFF = 2816, M = BATCH * SEQ, DEPTH = 4;
constexpr float RMS_EPS = 1e-6f, LOG2E = 1.4426950408889634f, QSCALE = 0.125f * LOG2E;
constexpr size_t MiB = 1u << 20;
constexpr size_t WS_W = 0, WS_BIG = 185 * MiB, WS_H = 281 * MiB, WS_F = 313 * MiB, WS_O = 377 * MiB, WS_STATS = 409 * MiB, WS_LSE = 410 * MiB, WS_BAR = 411 * MiB, WS_END = 412 * MiB;
constexpr size_t W_GU = (size_t)2 * DFF * D, W_DN = (size_t)D * DFF, W_FFN = W_GU + W_DN;
constexpr size_t WO_AIN = 8 * W_FFN, W_AIN = (size_t)9216 * D, WO_AOUT = WO_AIN + 2 * W_AIN, W_SQ = (size_t)D * D;
constexpr size_t WO_BIN = WO_AOUT + 2 * W_SQ, W_BIN = (size_t)3072 * D, WO_BOUT = WO_BIN + W_BIN, WO_CIN = WO_BOUT + W_SQ, W_CIN = (size_t)1280 * D, WO_COUT = WO_CIN + W_CIN, WO_END = WO_COUT + W_SQ;
static_assert(WO_END * 2 <= WS_BIG, "weights fit");
constexpr int LDS_BYTES = 131072 + 1024, MISC_OFF = 131072;
#define XB_TMO      128
#define XB_XCNT(j)  (256  + 64 * (j))
#define XB_XSUB(j)  (1280 + 64 * (j))
#define XB_XGEN(j)  (2304 + 64 * (j))
#define XB_TOP      3328
#define XB_TOPGEN   3392
#define XCD_BAR_WORDS 3456
#define XB_SPIN_CAP (1u << 18)

__device__ __forceinline__ unsigned xb_ld(unsigned* p)              { return __hip_atomic_load(p, __ATOMIC_RELAXED, __HIP_MEMORY_SCOPE_AGENT); }
__device__ __forceinline__ unsigned xb_add(unsigned* p, unsigned v) { return __hip_atomic_fetch_add(p, v, __ATOMIC_RELAXED, __HIP_MEMORY_SCOPE_AGENT); }
__device__ __forceinline__ unsigned xb_xcc_id() { return (unsigned)__builtin_amdgcn_s_getreg((3 << 11) | 20) & 0xFu; }
#define XB_SPIN(cond, bar) do { unsigned _sp = 0; while (cond) { __builtin_amdgcn_s_sleep(1); \
    if ((++_sp & 255u) == 0u) { if (xb_ld(&(bar)[XB_TMO])) break; if (_sp > XB_SPIN_CAP) { atomicAdd(&(bar)[XB_TMO], 1u); break; } } } } while (0)

struct XcdBarrier {
    unsigned* bar; unsigned x;
    volatile LAS unsigned* st;
};

__device__ __forceinline__ XcdBarrier xcd_barrier_post(unsigned* bar, volatile LAS unsigned* st) {
    XcdBarrier b; b.bar = bar; b.x = xb_xcc_id(); b.st = st;
    if (threadIdx.x == 0) (void)xb_add(&bar[XB_XCNT(b.x)], 1u);
    return b;
}
__device__ __forceinline__ void xcd_barrier_complete(unsigned* bar, unsigned x, unsigned& nloc, unsigned& nx) {
    const unsigned G = gridDim.x * gridDim.y * gridDim.z;
    unsigned sum, cnt, mine, sp = 0u;
    for (;;) {
        sum = 0u; cnt = 0u; mine = 0u;
#pragma unroll
        for (unsigned j = 0; j < 16; ++j) { const unsigned c = xb_ld(&bar[XB_XCNT(j)]); sum += c; cnt += (c > 0u) ? 1u : 0u; mine = (j == x) ? c : mine; }
        if (sum == G) break;
        __builtin_amdgcn_s_sleep(1);
        if ((++sp & 255u) == 0u) { if (xb_ld(&bar[XB_TMO])) break; if (sp > XB_SPIN_CAP) { atomicAdd(&bar[XB_TMO], 1u); break; } }
    }
    nloc = mine > 0u ? mine : 1u; nx = cnt > 0u ? cnt : 1u;
}

__device__ __forceinline__ void xcd_barrier(const XcdBarrier& b) {
    asm volatile("s_waitcnt vmcnt(0)" ::: "memory");
    __syncthreads();
    if (threadIdx.x == 0) {
        unsigned* bar = b.bar;
        __builtin_amdgcn_s_waitcnt(0);
        unsigned nloc = b.st[0], nx = b.st[1];
        if (nloc == 0u) { xcd_barrier_complete(bar, b.x, nloc, nx); b.st[0] = nloc; b.st[1] = nx; }
        const unsigned old = xb_add(&bar[XB_XSUB(b.x)], 1u);
        const unsigned gen = old / nloc;
        if (old + 1u == (gen + 1u) * nloc) {
            __builtin_amdgcn_fence(__ATOMIC_RELEASE, "agent");
            asm volatile("s_waitcnt vmcnt(0)" ::: "memory");
            const unsigned og = xb_add(&bar[XB_TOP], 1u);
            const unsigned tg = og / nx;
            if (og + 1u == (tg + 1u) * nx) xb_add(&bar[XB_TOPGEN], 1u);
            else XB_SPIN(xb_ld(&bar[XB_TOPGEN]) == tg, bar);
            __builtin_amdgcn_fence(__ATOMIC_ACQUIRE, "agent");
            xb_add(&bar[XB_XGEN(b.x)], 1u);
            asm volatile("s_waitcnt vmcnt(0)" ::: "memory");
        } else {
            XB_SPIN(xb_ld(&bar[XB_XGEN(b.x)]) == gen, bar);
            __builtin_amdgcn_fence(__ATOMIC_ACQUIRE, "agent");
            asm volatile("s_waitcnt vmcnt(0)" ::: "memory");
        }
    }
    __syncthreads();
}


__device__ __forceinline__ float wave_sum(float v) {
#pragma unroll
    for (int o = 1; o < 64; o <<= 1) v += __shfl_xor(v, o);
    return v;
}
__device__ __forceinline__ unsigned pk2(float lo, float hi) { return att::pk2(lo, hi); }

__device__ __forceinline__ void transpose_item(const float* __restrict__ W, int K, int N, bf16* WT, LAS float* scr, int item, int lane, int mode) {
    const int nblk = N / 32, kb = item / nblk, nb = item % nblk, k0 = 64 * kb, n0 = 32 * nb;
    int drow0 = n0;
    if (mode) drow0 = 256 * (n0 >> 7) + (n0 & 127) + (mode == 2 ? 128 : 0);
#pragma unroll 8
    for (int i = 0; i < 32; ++i) { const int kk = 2 * i + (lane >> 5); scr[kk * 33 + (lane & 31)] = W[(size_t)(k0 + kk) * N + n0 + (lane & 31)]; }
    asm volatile("s_waitcnt lgkmcnt(0)" ::: "memory");
    const int c = lane & 7;
#pragma unroll
    for (int j = 0; j < 4; ++j) { const int n = (lane >> 3) + 8 * j; const LAS float* s = scr + (8 * c) * 33 + n;
        v4u o; o.x = pk2(s[0 * 33], s[1 * 33]); o.y = pk2(s[2 * 33], s[3 * 33]); o.z = pk2(s[4 * 33], s[5 * 33]); o.w = pk2(s[6 * 33], s[7 * 33]);
        *(v4u*)(WT + (size_t)(drow0 + n) * K + k0 + 8 * c) = o; }
    asm volatile("s_waitcnt lgkmcnt(0)" ::: "memory");
}

struct Args {
    const float* x; const float* norm_pre; const float* norm_post; const float* wg; const float* wu; const float* wd;
    const float* a_in; const float* a_out; const float* b_in; const float* b_out; const float* b_lambda; const float* b_subln;
    const float* c_in; const float* c_bin; const float* c_out; const float* c_sinks;
    float* out; unsigned char* ws;
};

__device__ __forceinline__ void rowpass(const float* F, const float* stats, const float* xin, float* xout, const float* gpost, float coef, const float* gpre, bf16* hout, int gw, int NGW, int lane) {
    for (int m = gw; m < M; m += NGW) {
        const f32x4* fr = (const f32x4*)(F + (size_t)m * D) + lane; const f32x4* xr = (const f32x4*)(xin + (size_t)m * D) + lane;
        float st = (lane < 16) ? stats[(size_t)m * 16 + lane] : 0.f;
        f32x4 f[4], x[4];
#pragma unroll
        for (int j = 0; j < 4; ++j) { f[j] = fr[64 * j]; x[j] = xr[64 * j]; }
        const float rstd = coef * __builtin_amdgcn_rsqf(wave_sum(st) * (1.f / D) + RMS_EPS);
        float s2 = 0.f;
#pragma unroll
        for (int j = 0; j < 4; ++j) { const f32x4 g = *((const f32x4*)gpost + lane + 64 * j); x[j] = x[j] + f[j] * g * rstd; s2 += (x[j].x * x[j].x + x[j].y * x[j].y) + (x[j].z * x[j].z + x[j].w * x[j].w);
            *((f32x4*)(xout + (size_t)m * D) + lane + 64 * j) = x[j]; }
        if (gpre) {
            const float r2 = __builtin_amdgcn_rsqf(wave_sum(s2) * (1.f / D) + RMS_EPS);
            v2u* o8 = (v2u*)(hout + (size_t)m * D) + lane;
#pragma unroll
            for (int j = 0; j < 4; ++j) { const f32x4 g = *((const f32x4*)gpre + lane + 64 * j); const f32x4 y = x[j] * g * r2; v2u w; w.x = pk2(y.x, y.y); w.y = pk2(y.z, y.w); o8[64 * j] = w; }
        }
    }
}

__device__ __forceinline__ float alibi_slope(int h, int nheads) { return exp2f(-8.0f * (float)(h + 1) / (float)nheads); }

__device__ __forceinline__ void prologue_phase(const Args& a, LAS unsigned char* lds, int gw, int NGW, int wave, int lane) {
    bf16* Wt = (bf16*)(a.ws + WS_W); bf16* Hb = (bf16*)(a.ws + WS_H);
    LAS float* scr = (LAS float*)(lds + wave * 16384);
    constexpr int I_FFN = 1408, N_FFN = 24 * I_FFN, I_AIN = 16 * 288, I_SQ = 512, I_BIN = 16 * 96, I_CIN = 16 * 40;
    constexpr int NITEMS = N_FFN + 2 * I_AIN + 2 * I_SQ + I_BIN + I_SQ + I_CIN + I_SQ;
    for (int it = gw; it < NITEMS; it += NGW) {
        int r = it; const float* src; bf16* dst; int K = D, N = D, mode = 0;
        if (r < N_FFN) { const int mi = r / I_FFN, f = mi / 3, kind = mi % 3; r -= mi * I_FFN;
            if (kind == 0) { src = a.wg + (size_t)f * D * DFF; dst = Wt + f * W_FFN; N = DFF; mode = 1; }
            else if (kind == 1) { src = a.wu + (size_t)f * D * DFF; dst = Wt + f * W_FFN; N = DFF; mode = 2; }
            else { src = a.wd + (size_t)f * DFF * D; dst = Wt + f * W_FFN + W_GU; K = DFF; }
        } else { r -= N_FFN;
            if (r < 2 * I_AIN) { const int j = r / I_AIN; r -= j * I_AIN; src = a.a_in + (size_t)j * D * 9216; dst = Wt + WO_AIN + j * W_AIN; N = 9216; }
            else { r -= 2 * I_AIN;
                if (r < 2 * I_SQ) { const int j = r / I_SQ; r -= j * I_SQ; src = a.a_out + (size_t)j * D * D; dst = Wt + WO_AOUT + j * W_SQ; }
                else { r -= 2 * I_SQ;
                    if (r < I_BIN) { src = a.b_in; dst = Wt + WO_BIN; N = 3072; }
                    else { r -= I_BIN;
                        if (r < I_SQ) { src = a.b_out; dst = Wt + WO_BOUT; }
                        else { r -= I_SQ;
                            if (r < I_CIN) { src = a.c_in; dst = Wt + WO_CIN; N = 1280; }
                            else { r -= I_CIN; src = a.c_out; dst = Wt + WO_COUT; } } } } } }
        transpose_item(src, K, N, dst, scr, r, lane, mode);
    }
    for (int m = gw; m < M; m += NGW) {
        const f32x4* xr = (const f32x4*)(a.x + (size_t)m * D) + lane; f32x4 x[4]; float s2 = 0.f;
#pragma unroll
        for (int j = 0; j < 4; ++j) { x[j] = xr[64 * j]; s2 += (x[j].x * x[j].x + x[j].y * x[j].y) + (x[j].z * x[j].z + x[j].w * x[j].w); }
        const float r2 = __builtin_amdgcn_rsqf(wave_sum(s2) * (1.f / D) + RMS_EPS);
        v2u* o8 = (v2u*)(Hb + (size_t)m * D) + lane;
#pragma unroll
        for (int j = 0; j < 4; ++j) { const f32x4 g = *((const f32x4*)a.norm_pre + lane + 64 * j); const f32x4 y = x[j] * g * r2; v2u w; w.x = pk2(y.x, y.y); w.y = pk2(y.z, y.w); o8[64 * j] = w; }
    }
}

__device__ __forceinline__ void attn_a_phase(const Args& a, LAS unsigned char* lds, int gi, int bid, int G, int wave, int lane) {
    const bf16* BIG = (const bf16*)(a.ws + WS_BIG); float* Fb = (float*)(a.ws + WS_F); bf16* Ob = (bf16*)(a.ws + WS_O); float* lse_run = (float*)(a.ws + WS_LSE);
    const int dil = (gi == 0) ? 1 : (gi == 1) ? 4 : 16; const int nsub = SEQ / dil, nqb = nsub / 256;
    for (int u = bid; u < 1024; u += G) {
        const int qb = u % nqb; int t = u / nqb; const int cls = t % dil; t /= dil; const int h = t & 15, b = t >> 4;
        const bf16* base = BIG + ((size_t)b * SEQ + cls) * 3072 + h * 64;
        const int n0 = qb * 256; const int kt_lo = (n0 >= 128) ? (n0 / 64 - 2) : 0, kt_hi = n0 / 64 + 4;
        const float slope2 = alibi_slope(h, 16) * (float)dil * LOG2E;
        att::f32x16 o[2]; float mrun = -1e30f, lrun = 0.f;
        att::core<64>(lds, base, base + 1024, base + 2048, (long)dil * 3072, n0, kt_lo, kt_hi, 128, slope2, o, mrun, lrun);
        const int l32 = lane & 31, hi = lane >> 5;
        lrun += __shfl_xor(lrun, 32);
        const float inv = 1.f / lrun; float lse = mrun + __log2f(lrun);
        const size_t tok = (size_t)b * SEQ + (size_t)(n0 + wave * 32 + l32) * dil + cls;
        float w_old = 0.f, w_new = 1.f;
        if (gi > 0) { const float lo = lse_run[tok * 16 + h]; const float mm = fmaxf(lo, lse); const float e0 = __builtin_amdgcn_exp2f(lo - mm), e1 = __builtin_amdgcn_exp2f(lse - mm);
            const float rs = 1.f / (e0 + e1); w_old = e0 * rs; w_new = e1 * rs; lse = mm + __log2f(e0 + e1); }
        if (gi < 2 && hi == 0) lse_run[tok * 16 + h] = lse;
        w_new *= inv;
#pragma unroll
        for (int d0 = 0; d0 < 2; ++d0)
#pragma unroll
            for (int gq = 0; gq < 4; ++gq) {
                const int d = d0 * 32 + 8 * gq + 4 * hi;
                f32x4 v = {o[d0][4 * gq] * w_new, o[d0][4 * gq + 1] * w_new, o[d0][4 * gq + 2] * w_new, o[d0][4 * gq + 3] * w_new};
                float* fp = Fb + tok * D + h * 64 + d;
                if (gi > 0) { const f32x4 old = *(const f32x4*)fp; v = v + old * w_old; }
                if (gi < 2) *(f32x4*)fp = v;
                else { v2u w; w.x = pk2(v.x, v.y); w.y = pk2(v.z, v.w); *(v2u*)(Ob + tok * D + h * 64 + d) = w; }
            }
    }
}

__device__ __forceinline__ void attn_b_phase(const Args& a, LAS unsigned char* lds, int layer, int bid, int G, int wave, int lane) {
    const bf16* BIG = (const bf16*)(a.ws + WS_BIG); float* Fb = (float*)(a.ws + WS_F); bf16* Ob = (bf16*)(a.ws + WS_O);
    const int jm = layer / 3;
    const float lambda_init = 0.8f - 0.6f * expf(-0.3f * (float)layer);
    const float* lam = a.b_lambda + (size_t)jm * 256;
    const float d1 = wave_sum(lam[lane] * lam[64 + lane]), d2 = wave_sum(lam[128 + lane] * lam[192 + lane]);
    const float lam_full = expf(d1) - expf(d2) + lambda_init;
    const float* subln = a.b_subln + (size_t)jm * 128;
    const int l32 = lane & 31, hi = lane >> 5;
    for (int u2 = bid; u2 < 1024; u2 += G) {
        const int u = u2 & 255, ps = u2 >> 8; const int c = ps & 1;
        const int s = u & 15, h = (u >> 4) & 7, b = u >> 7;
        const int qb = (ps >> 1) ? 31 - s : s; const int n0 = qb * 256;
        const size_t tok = (size_t)b * SEQ + n0 + wave * 32 + l32;
        const int hh = 2 * h + c;
        const bf16* base = BIG + (size_t)b * SEQ * 3072;
        const float slope2 = alibi_slope(h, 8) * LOG2E;
        att::f32x16 o[4]; float mrun = -1e30f, lrun = 0.f;
        att::core<128>(lds, base + hh * 64, base + 1024 + hh * 64, base + 2048 + h * 128, 3072L, n0, 0, n0 / 64 + 4, 1 << 30, slope2, o, mrun, lrun);
        lrun += __shfl_xor(lrun, 32);
        const float inv = 1.f / lrun;
        if (c == 0) {
#pragma unroll
            for (int d0 = 0; d0 < 4; ++d0)
#pragma unroll
                for (int gq = 0; gq < 4; ++gq) { const int d = d0 * 32 + 8 * gq + 4 * hi;
                    *(f32x4*)(Fb + tok * D + h * 128 + d) = (f32x4){o[d0][4 * gq] * inv, o[d0][4 * gq + 1] * inv, o[d0][4 * gq + 2] * inv, o[d0][4 * gq + 3] * inv}; }
        } else {
            const float sc2 = -lam_full * inv; float ss = 0.f;
#pragma unroll
            for (int d0 = 0; d0 < 4; ++d0)
#pragma unroll
                for (int gq = 0; gq < 4; ++gq) { const int d = d0 * 32 + 8 * gq + 4 * hi; const f32x4 o1 = *(const f32x4*)(Fb + tok * D + h * 128 + d);
#pragma unroll
                    for (int j = 0; j < 4; ++j) { const float df = o1[j] + sc2 * o[d0][4 * gq + j]; o[d0][4 * gq + j] = df; ss += df * df; } }
            ss += __shfl_xor(ss, 32);
            const float rs = __builtin_amdgcn_rsqf(ss * (1.f / 128.f) + RMS_EPS) * (1.f - lambda_init);
#pragma unroll
            for (int d0 = 0; d0 < 4; ++d0)
#pragma unroll
                for (int gq = 0; gq < 4; ++gq) { const int d = d0 * 32 + 8 * gq + 4 * hi; const f32x4 gs = *(const f32x4*)(subln + d);
                    v2u w; w.x = pk2(o[d0][4 * gq] * rs * gs.x, o[d0][4 * gq + 1] * rs * gs.y); w.y = pk2(o[d0][4 * gq + 2] * rs * gs.z, o[d0][4 * gq + 3] * rs * gs.w);
                    *(v2u*)(Ob + tok * D + h * 128 + d) = w; }
        }
    }
}

__device__ __forceinline__ void attn_c_phase(const Args& a, LAS unsigned char* lds, int jm, int bid, int G, int wave, int lane) {
    const bf16* BIG = (const bf16*)(a.ws + WS_BIG); bf16* Ob = (bf16*)(a.ws + WS_O);
    for (int u = bid; u < 1024; u += G) {
        const int qb = u & 31, h = (u >> 5) & 15, b = u >> 9; const int kvh = h >> 3;
        const bf16* base = BIG + (size_t)b * SEQ * 1280;
        const int n0 = qb * 256; const int kt_lo = (n0 >= 128) ? (n0 / 64 - 2) : 0, kt_hi = n0 / 64 + 4;
        const float slope2 = alibi_slope(h, 16) * LOG2E;
        const int l32 = lane & 31, hi = lane >> 5;
        att::f32x16 o[2]; float mrun = a.c_sinks[jm * 16 + h] * LOG2E, lrun = (hi == 0) ? 1.f : 0.f;
        att::core<64>(lds, base + h * 64, base + 1024 + kvh * 64, base + 1152 + kvh * 64, 1280L, n0, kt_lo, kt_hi, 127, slope2, o, mrun, lrun);
        lrun += __shfl_xor(lrun, 32);
        const float inv = 1.f / lrun;
        const size_t tok = (size_t)b * SEQ + n0 + wave * 32 + l32;
#pragma unroll
        for (int d0 = 0; d0 < 2; ++d0)
#pragma unroll
            for (int gq = 0; gq < 4; ++gq) { const int d = d0 * 32 + 8 * gq + 4 * hi;
                v2u w; w.x = pk2(o[d0][4 * gq] * inv, o[d0][4 * gq + 1] * inv); w.y = pk2(o[d0][4 * gq + 2] * inv, o[d0][4 * gq + 3] * inv);
                *(v2u*)(Ob + tok * D + h * 64 + d) = w; }
    }
}

constexpr int STEPS = 14;
__global__ void __launch_bounds__(NWAVES * 64, 2) mega_fwd(Args a) {
    extern __shared__ __attribute__((aligned(16))) unsigned char lds_raw[];
    LAS unsigned char* lds = (LAS unsigned char*)lds_raw;
    cg::grid_group grid = cg::this_grid();
    unsigned* barw = (unsigned*)(a.ws + WS_BAR);
    if (blockIdx.x == 0) for (int i = threadIdx.x; i < XCD_BAR_WORDS; i += NWAVES * 64) __hip_atomic_store(barw + i, 0u, __ATOMIC_RELAXED, __HIP_MEMORY_SCOPE_AGENT);
    if (threadIdx.x < 32) ((volatile LAS unsigned*)(lds + MISC_OFF))[threadIdx.x] = 0u;
    prologue_phase(a, lds, blockIdx.x * NWAVES + __builtin_amdgcn_readfirstlane(threadIdx.x >> 6), gridDim.x * NWAVES, __builtin_amdgcn_readfirstlane(threadIdx.x >> 6), threadIdx.x & 63);
    grid.sync();
    const XcdBarrier bar = xcd_barrier_post(barw, (volatile LAS unsigned*)(lds + MISC_OFF) + 8);
#pragma unroll 1
    for (int ph = 0; ph < DEPTH * STEPS; ++ph) {
        const int layer = ph / STEPS, st = ph % STEPS; const int kind = layer % 3, jm = layer / 3;
        if (kind != 0 && st >= 5 && st <= 8) continue;
        const int G = gridDim.x, bid = blockIdx.x; const int tid_ = opaque_tid(); const int lane = tid_ & 63; const int wave = __builtin_amdgcn_readfirstlane(tid_ >> 6);
        unsigned char* ws = a.ws;
        bf16* Wt = (bf16*)(ws + WS_W);
        if (st == 0 || st == 11) {
            const int f = layer * 2 + (st == 11);
            pg8::Gemm g{(const bf16*)(ws + WS_H), Wt + f * W_FFN, M, 2 * DFF, D}; pg8::StaticOrder S; S.init(M, 2 * DFF, G, bid);
            pg8::EpiSwiGLU E{(bf16*)(ws + WS_BIG), DFF};
            pg8::gemm_phase<pg8::EpiSwiGLU, pg8::StaticOrder, true, true>(lds, g, S, E);
        } else if (st == 1 || st == 12 || st == 9) {
            pg8::Gemm g; g.M = M; g.N = D;
            if (st == 9) { g.A = (const bf16*)(ws + WS_O); g.K = D; g.Bt = (kind == 0) ? Wt + WO_AOUT + jm * W_SQ : (kind == 1) ? Wt + WO_BOUT : Wt + WO_COUT; }
            else { const int f = layer * 2 + (st == 12); g.A = (const bf16*)(ws + WS_BIG); g.K = DFF; g.Bt = Wt + f * W_FFN + W_GU; }
            pg8::StaticOrder S; S.init(M, D, G, bid);
            pg8::EpiF32Stats E{(float*)(ws + WS_F), D, (float*)(ws + WS_STATS)};
            pg8::gemm_phase<pg8::EpiF32Stats, pg8::StaticOrder, true, true>(lds, g, S, E);
        } else if (st == 3 || st == 5 || st == 7) {
            pg8::Gemm g; g.A = (const bf16*)(ws + WS_H); g.M = M; g.K = D; const float* bias = nullptr;
            if (kind == 0) { g.N = 3072; g.Bt = Wt + WO_AIN + jm * W_AIN + (size_t)((st - 3) >> 1) * 3072 * D; }
            else if (kind == 1) { g.N = 3072; g.Bt = Wt + WO_BIN; }
            else { g.N = 1280; g.Bt = Wt + WO_CIN; bias = a.c_bin + (size_t)jm * 1280; }
            pg8::StaticOrder S; S.init(M, g.N, G, bid);
            pg8::EpiProj E{(bf16*)(ws + WS_BIG), g.N, bias, QSCALE};
            pg8::gemm_phase<pg8::EpiProj, pg8::StaticOrder, true, true>(lds, g, S, E);
        } else if (st == 4 || st == 6 || st == 8) {
            if (kind == 0) attn_a_phase(a, lds, (st - 4) >> 1, bid, G, wave, lane);
            else if (kind == 1) attn_b_phase(a, lds, layer, bid, G, wave, lane);
            else attn_c_phase(a, lds, jm, bid, G, wave, lane);
        } else {
            const int gw = bid * NWAVES + wave, NGW = G * NWAVES;
            const int pi = (st == 2) ? 0 : (st == 10) ? 1 : 2;
            const float* gpre = (pi < 2) ? a.norm_pre + (size_t)(layer * 3 + pi + 1) * D : (layer + 1 < DEPTH ? a.norm_pre + (size_t)((layer + 1) * 3) * D : nullptr);
            const float* xin = (ph == 2) ? a.x : a.out;
            rowpass((const float*)(ws + WS_F), (const float*)(ws + WS_STATS), xin, a.out, a.norm_post + (size_t)(layer * 3 + pi) * D, (pi == 1) ? 1.0f : 0.5f, gpre, (bf16*)(ws + WS_H), gw, NGW, lane);
        }
        if (ph != DEPTH * STEPS - 1) xcd_barrier(bar);
    }
}

extern "C" void kernel_launch(void* const* d_in, const int* in_sizes, int n_in, void* d_out, int out_size, void* d_ws, size_t ws_size, hipStream_t stream) {
    static int grid_blocks = 0;
    if (grid_blocks == 0) {
        if (n_in != 16 || in_sizes[0] != M * D || out_size != M * D || ws_size < WS_END) { fprintf(stderr, "kernel_launch: unexpected shapes / workspace (%d inputs, ws %zu)\n", n_in, ws_size); grid_blocks = -1; return; }
        int dev = 0, cus = 0, per_cu = 0;
        hipGetDevice(&dev);
        hipDeviceGetAttribute(&cus, hipDeviceAttributeMultiprocessorCount, dev);
        if (hipFuncSetAttribute((const void*)mega_fwd, hipFuncAttributeMaxDynamicSharedMemorySize, LDS_BYTES) != hipSuccess) { fprintf(stderr, "hipFuncSetAttribute failed\n"); grid_blocks = -1; return; }
        if (hipOccupancyMaxActiveBlocksPerMultiprocessor(&per_cu, (const void*)mega_fwd, NWAVES * 64, LDS_BYTES) != hipSuccess || per_cu < 1) { fprintf(stderr, "occupancy query failed (%d)\n", per_cu); per_cu = 1; }
        (void)hipGetLastError();
        grid_blocks = cus * per_cu;
    }
    if (grid_blocks < 0) return;
    Args a{};
    a.x = (const float*)d_in[0]; a.norm_pre = (const float*)d_in[1]; a.norm_post = (const float*)d_in[2]; a.wg = (const float*)d_in[3]; a.wu = (const float*)d_in[4]; a.wd = (const float*)d_in[5];
    a.a_in = (const float*)d_in[6]; a.a_out = (const float*)d_in[7]; a.b_in = (const float*)d_in[8]; a.b_out = (const float*)d_in[9]; a.b_lambda = (const float*)d_in[10]; a.b_subln = (const float*)d_in[11];
    a.c_in = (const float*)d_in[12]; a.c_bin = (const float*)d_in[13]; a.c_out = (const float*)d_in[14]; a.c_sinks = (const float*)d_in[15];
    a.out = (float*)d_out; a.ws = (unsigned char*)d_ws;
    void* args[] = {&a};
    hipError_t e = hipLaunchCooperativeKernel((const void*)mega_fwd, dim3(grid_blocks), dim3(NWAVES * 64), args, LDS_BYTES, stream);
    if (e != hipSuccess) fprintf(stderr, "cooperative launch failed: %s (grid %d)\n", hipGetErrorString(e), grid_blocks);
}
```

```cpp
#include <hip/hip_runtime.h>
#include <hip/hip_cooperative_groups.h>
#include <cstdio>
#include <cstdint>
#include <cmath>
__device__ __forceinline__ int opaque_tid() { int t = threadIdx.x; asm volatile("" : "+v"(t)); return t; }
namespace pg8 {
#define PG8_LAS __attribute__((address_space(3)))
typedef unsigned short bf16_t;
typedef short bf16x8 __attribute__((ext_vector_type(8)));
typedef float f32x4 __attribute__((ext_vector_type(4)));
typedef unsigned u32x4 __attribute__((ext_vector_type(4)));
constexpr int BM = 256, BK = 64, HALF = 128, HTB = HALF * BK * 2  , STAGE_BYTES = 8 * HTB, NXCD = 8, WGM = 8;

__host__ __device__ __forceinline__ int lds_byte(int r, int c) { const int st = (r >> 4) * 2 + (c >> 5), rr = r & 15, cc = c & 31, ob = rr * 64 + cc * 2; return st * 1024 + (ob ^ (((ob >> 9) & 1) << 5)); }
__host__ __device__ __forceinline__ void stage_rc(int b, int& R, int& C) { const int st = b / 1024, sb = b % 1024, swz = sb ^ (((sb >> 9) & 1) << 5); R = (st >> 1) * 16 + swz / 64; C = (st & 1) * 32 + (swz % 64) / 2; }
__host__ __device__ __forceinline__ int perm32(int rho) { const int n = rho >> 4, i = rho & 15; return 8 * (i >> 2) + 4 * n + (i & 3); }

struct Unit { int pm, pn; };
struct Gemm { const bf16_t* A; const bf16_t* Bt; int M, N, K; };

struct StaticOrder {
    int nM, nN, nwg, G, c;
    __host__ __device__ void init(int M, int N, int G_, int c_) { nM = M / BM; nN = N / BM; nwg = nM * nN; G = G_; c = c_; }
    __host__ __device__ bool next(int i, Unit& u) const {
        const long L = (long)i * G + c; if (L >= nwg) return false;
        int wgid = (int)L; { const int q = nwg / NXCD, r = nwg % NXCD, xcd = wgid % NXCD, off = wgid / NXCD; wgid = (xcd < r ? xcd * (q + 1) : r * (q + 1) + (xcd - r) * q) + off; }
        const int nig = WGM * nN, gid = wgid / nig, fm = gid * WGM, gsz = (nM - fm) < WGM ? (nM - fm) : WGM;
        u.pm = fm + ((wgid % nig) % gsz); u.pn = (wgid % nig) / gsz; return true;
    }
    __device__ __forceinline__ void a_ready(const Unit&) const {}
    __device__ __forceinline__ void done(const Unit&) const {}
};


typedef float f32x2 __attribute__((ext_vector_type(2)));
typedef __bf16 bf16x2_t __attribute__((ext_vector_type(2)));
__device__ __forceinline__ unsigned cvt_pk_bf16(float lo, float hi) { f32x2 v = {lo, hi}; bf16x2_t b = __builtin_convertvector(v, bf16x2_t); return __builtin_bit_cast(unsigned, b); }

struct EpiProj {
    static constexpr bool PERM = true, AFTER_DRAIN = false;
    bf16_t* O; int ldc; const float* bias; float qscale;
    __device__ __forceinline__ void operator()(const f32x4 (&acc)[2][2][4][2], const Unit& u, int wr, int wc, int fr, int fq) const {
        const int row0 = u.pm * BM + wr * 64 + fr; const int colt = u.pn * BM;
        const float sc = (((colt >> 10) % 3) == 0) ? qscale : 1.f;
        const int col0 = colt + wc * 32 + 8 * fq;
        f32x4 bv[2][2];
#pragma unroll
        for (int bj = 0; bj < 2; ++bj)
#pragma unroll
            for (int n = 0; n < 2; ++n) bv[bj][n] = bias ? *(const f32x4*)(bias + col0 + bj * HALF + 4 * n) : (f32x4){0.f, 0.f, 0.f, 0.f};
#pragma unroll
        for (int ai = 0; ai < 2; ++ai)
#pragma unroll
            for (int m = 0; m < 4; ++m) { bf16_t* rowp = O + (size_t)(row0 + ai * HALF + m * 16) * ldc + col0;
#pragma unroll
                for (int bj = 0; bj < 2; ++bj) { f32x4 v0 = (acc[ai][bj][m][0] + bv[bj][0]) * sc, v1 = (acc[ai][bj][m][1] + bv[bj][1]) * sc;
                    u32x4 w; w.x = cvt_pk_bf16(v0[0], v0[1]); w.y = cvt_pk_bf16(v0[2], v0[3]); w.z = cvt_pk_bf16(v1[0], v1[1]); w.w = cvt_pk_bf16(v1[2], v1[3]);
                    *(u32x4*)(rowp + bj * HALF) = w; } }
    }
};

struct EpiSwiGLU {
    static constexpr bool PERM = true, AFTER_DRAIN = false;
    bf16_t* O; int ldc;
    __device__ __forceinline__ void operator()(const f32x4 (&acc)[2][2][4][2], const Unit& u, int wr, int wc, int fr, int fq) const {
        const int row0 = u.pm * BM + wr * 64 + fr; const int col0 = u.pn * HALF + wc * 32 + 8 * fq;
#pragma unroll
        for (int ai = 0; ai < 2; ++ai)
#pragma unroll
            for (int m = 0; m < 4; ++m) { bf16_t* rowp = O + (size_t)(row0 + ai * HALF + m * 16) * ldc + col0;
                float r[8];
#pragma unroll
                for (int n = 0; n < 2; ++n)
#pragma unroll
                    for (int j = 0; j < 4; ++j) { const float g = acc[ai][0][m][n][j], up = acc[ai][1][m][n][j];
                        const float e = __builtin_amdgcn_exp2f(g * -1.4426950408889634f);
                        r[n * 4 + j] = g * __builtin_amdgcn_rcpf(1.f + e) * up; }
                u32x4 w; w.x = cvt_pk_bf16(r[0], r[1]); w.y = cvt_pk_bf16(r[2], r[3]); w.z = cvt_pk_bf16(r[4], r[5]); w.w = cvt_pk_bf16(r[6], r[7]);
                *(u32x4*)rowp = w; }
    }
};

struct EpiF32Stats {
    static constexpr bool PERM = false, AFTER_DRAIN = false;
    float* F; int ldc; float* stats;
    __device__ __forceinline__ void operator()(const f32x4 (&acc)[2][2][4][2], const Unit& u, int wr, int wc, int fr, int fq) const {
        const int row0 = u.pm * BM + wr * 64 + fr; const int col0 = u.pn * BM + wc * 32 + 4 * fq;
#pragma unroll
        for (int ai = 0; ai < 2; ++ai)
#pragma unroll
            for (int m = 0; m < 4; ++m) { const int row = row0 + ai * HALF + m * 16; float* rowp = F + (size_t)row * ldc + col0; float s = 0.f;
#pragma unroll
                for (int bj = 0; bj < 2; ++bj)
#pragma unroll
                    for (int n = 0; n < 2; ++n) { const f32x4 v = acc[ai][bj][m][n]; s += (v[0] * v[0] + v[1] * v[1]) + (v[2] * v[2] + v[3] * v[3]); *(f32x4*)(rowp + bj * HALF + n * 16) = v; }
                s += __shfl_xor(s, 16); s += __shfl_xor(s, 32);
                if (fq == 0) stats[(size_t)row * 16 + u.pn * 4 + wc] = s; }
    }
};
template <class Epi, class Sched, bool ALIGN_EPI = false, bool SP2 = false>
__device__ __forceinline__ void gemm_phase(PG8_LAS unsigned char* lds, const Gemm g, const Sched& S, const Epi& E) {
    const int tid = opaque_tid(), wid = __builtin_amdgcn_readfirstlane(tid >> 6), lane = tid & 63, wr = wid >> 2, wc = wid & 3, fr = lane & 15, fq = lane >> 4;
    const int K = g.K, nt = K / BK;
    unsigned voffA[2], voffB[2];
#pragma unroll
    for (int i = 0; i < 2; ++i) { int R, C; stage_rc(tid * 16 + i * 8192, R, C); const int Rb = Epi::PERM ? ((R & ~31) + perm32(R & 31)) : R;
        voffA[i] = (unsigned)(R * K + C) * 2u; voffB[i] = (unsigned)(Rb * K + C) * 2u; }
    const size_t kstep = (size_t)(BK * 2);
    const size_t hstep = (size_t)HALF * K * 2;
    const size_t tstep = 2 * hstep;
    const unsigned ldsw = (unsigned)wid * 1024u;
    const int aoff = lds_byte(wr * 64 + fr, fq * 8), boff = lds_byte(wc * 32 + fr, fq * 8);
#define PG8_SA(b, h) (((b) * 2 + (h)) * HTB)
#define PG8_SB(b, h) ((4 + (b) * 2 + (h)) * HTB)
#define PG8_STAGE(bufoff, gbase, voff) do { _Pragma("unroll") for (int _i = 0; _i < 2; ++_i) \
        __builtin_amdgcn_global_load_lds((const unsigned*)((const char*)(gbase) + (voff)[_i]), (PG8_LAS unsigned*)(lds + (bufoff) + ldsw + _i * 8192), 16, 0, 0); } while (0)
#define PG8_LDA(dst, b, h) do { _Pragma("unroll") for (int m = 0; m < 4; ++m) _Pragma("unroll") for (int k = 0; k < 2; ++k) dst[m][k] = *(const PG8_LAS bf16x8*)(lds + PG8_SA(b, h) + aoff + m * 2048 + k * 1024); } while (0)
#define PG8_LDB(dst, b, h) do { _Pragma("unroll") for (int n = 0; n < 2; ++n) _Pragma("unroll") for (int k = 0; k < 2; ++k) dst[n][k] = *(const PG8_LAS bf16x8*)(lds + PG8_SB(b, h) + boff + n * 2048 + k * 1024); } while (0)
#define PG8_MMA(ai, bj, At, Bt) do { __builtin_amdgcn_s_setprio(1); _Pragma("unroll") for (int m = 0; m < 4; ++m) _Pragma("unroll") for (int n = 0; n < 2; ++n) _Pragma("unroll") for (int k = 0; k < 2; ++k) \
        acc[ai][bj][m][n] = __builtin_amdgcn_mfma_f32_16x16x32_bf16(Bt[n][k], At[m][k], acc[ai][bj][m][n], 0, 0, 0); __builtin_amdgcn_s_setprio(0); } while (0)
#define PG8_WAIT_V(n) asm volatile("s_waitcnt vmcnt(" #n ")" ::: "memory")
#define PG8_WAIT_L(n) asm volatile("s_waitcnt lgkmcnt(" #n ")" ::: "memory")
#define PG8_BAR __builtin_amdgcn_s_barrier()
#define PG8_SCHED __builtin_amdgcn_sched_barrier(0)
    Unit cur, nxt; int ui = 0;
    if (!S.next(0, cur)) return;
    f32x4 acc[2][2][4][2];
#pragma unroll
    for (int a = 0; a < 2; ++a)
#pragma unroll
        for (int b = 0; b < 2; ++b)
#pragma unroll
            for (int m = 0; m < 4; ++m)
#pragma unroll
                for (int n = 0; n < 2; ++n) acc[a][b][m][n] = (f32x4){0.f, 0.f, 0.f, 0.f};
    bf16x8 At[4][2], B0[2][2], B1[2][2];
    const char* cA = (const char*)g.A + (size_t)cur.pm * tstep; const char* cB = (const char*)g.Bt + (size_t)cur.pn * tstep;
    S.a_ready(cur);
    if constexpr (SP2) {
        PG8_STAGE(PG8_SB(0, 0), cB, voffB); PG8_STAGE(PG8_SB(0, 1), cB + hstep, voffB); PG8_STAGE(PG8_SA(0, 0), cA, voffA); PG8_STAGE(PG8_SA(0, 1), cA + hstep, voffA);
        if (wr == 1) PG8_BAR;
        PG8_WAIT_V(2); PG8_BAR;
        PG8_STAGE(PG8_SB(1, 0), cB + kstep, voffB); PG8_STAGE(PG8_SA(1, 0), cA + kstep, voffA); PG8_STAGE(PG8_SB(1, 1), cB + hstep + kstep, voffB);
        PG8_WAIT_V(6); PG8_BAR;
    } else {
        PG8_STAGE(PG8_SB(0, 0), cB, voffB); PG8_STAGE(PG8_SA(0, 0), cA, voffA); PG8_STAGE(PG8_SB(0, 1), cB + hstep, voffB); PG8_STAGE(PG8_SA(0, 1), cA + hstep, voffA);
        if (wr == 1) PG8_BAR;
        PG8_WAIT_V(4); PG8_BAR;
        PG8_STAGE(PG8_SB(1, 0), cB + kstep, voffB); PG8_STAGE(PG8_SA(1, 0), cA + kstep, voffA); PG8_STAGE(PG8_SB(1, 1), cB + hstep + kstep, voffB);
        PG8_WAIT_V(6); PG8_BAR;
    }
    for (;;) {
        const bool has_next = S.next(ui + 1, nxt);
        const char* nA = has_next ? (const char*)g.A + (size_t)nxt.pm * tstep : cA; const char* nB = has_next ? (const char*)g.Bt + (size_t)nxt.pn * tstep : cB;
        for (int t = 0; t < nt; t += 2) {
            const bool last = (t == nt - 2);
            const char* a1 = cA + (size_t)(t + 1) * kstep;
            const char* a2 = last ? nA : cA + (size_t)(t + 2) * kstep; const char* b2 = last ? nB : cB + (size_t)(t + 2) * kstep;
            const char* a3 = a2 + kstep; const char* b3 = b2 + kstep;
            if (last && has_next) S.a_ready(nxt);
            if constexpr (SP2) {
            PG8_LDB(B0, 0, 0); PG8_LDB(B1, 0, 1); PG8_SCHED; PG8_LDA(At, 0, 0); PG8_STAGE(PG8_SA(1, 1), a1 + hstep, voffA);
            PG8_WAIT_V(8); PG8_WAIT_L(0); PG8_BAR; PG8_MMA(0, 0, At, B0); PG8_MMA(0, 1, At, B1); PG8_BAR; PG8_SCHED;
            PG8_LDA(At, 0, 1); PG8_STAGE(PG8_SB(0, 0), b2, voffB); PG8_STAGE(PG8_SB(0, 1), b2 + hstep, voffB); PG8_STAGE(PG8_SA(0, 0), a2, voffA);
            PG8_WAIT_V(8); PG8_WAIT_L(0); PG8_BAR; PG8_MMA(1, 0, At, B0); PG8_MMA(1, 1, At, B1); PG8_BAR; PG8_SCHED;
            PG8_LDB(B0, 1, 0); PG8_LDB(B1, 1, 1); PG8_SCHED; PG8_LDA(At, 1, 0); PG8_STAGE(PG8_SA(0, 1), a2 + hstep, voffA);
            PG8_WAIT_V(8); PG8_WAIT_L(0); PG8_BAR; PG8_MMA(0, 0, At, B0); PG8_MMA(0, 1, At, B1); PG8_BAR; PG8_SCHED;
            PG8_LDA(At, 1, 1); PG8_STAGE(PG8_SB(1, 0), b3, voffB); PG8_STAGE(PG8_SB(1, 1), b3 + hstep, voffB); PG8_STAGE(PG8_SA(1, 0), a3, voffA);
            PG8_WAIT_V(8); PG8_WAIT_L(0); PG8_BAR; PG8_MMA(1, 0, At, B0); PG8_MMA(1, 1, At, B1); PG8_BAR; PG8_SCHED;
            } else {
            PG8_LDB(B0, 0, 0); PG8_SCHED; PG8_LDA(At, 0, 0); PG8_STAGE(PG8_SA(1, 1), a1 + hstep, voffA);
            PG8_WAIT_L(8); PG8_BAR; PG8_WAIT_L(0); PG8_MMA(0, 0, At, B0); PG8_BAR; PG8_SCHED;
            PG8_LDB(B1, 0, 1); PG8_STAGE(PG8_SB(0, 0), b2, voffB);
            PG8_BAR; PG8_WAIT_L(0); PG8_MMA(0, 1, At, B1); PG8_BAR;
            PG8_LDA(At, 0, 1); PG8_STAGE(PG8_SA(0, 0), a2, voffA);
            PG8_BAR; PG8_WAIT_L(0); PG8_MMA(1, 0, At, B0); PG8_BAR; PG8_SCHED;
            PG8_STAGE(PG8_SB(0, 1), b2 + hstep, voffB);
            PG8_WAIT_V(6); PG8_BAR; PG8_MMA(1, 1, At, B1); PG8_BAR;
            PG8_LDB(B0, 1, 0); PG8_SCHED; PG8_LDA(At, 1, 0); PG8_STAGE(PG8_SA(0, 1), a2 + hstep, voffA);
            PG8_WAIT_L(8); PG8_BAR; PG8_WAIT_L(0); PG8_MMA(0, 0, At, B0); PG8_BAR; PG8_SCHED;
            PG8_LDB(B1, 1, 1); PG8_STAGE(PG8_SB(1, 0), b3, voffB);
            PG8_BAR; PG8_WAIT_L(0); PG8_MMA(0, 1, At, B1); PG8_BAR;
            PG8_LDA(At, 1, 1); PG8_STAGE(PG8_SA(1, 0), a3, voffA);
            PG8_BAR; PG8_WAIT_L(0); PG8_MMA(1, 0, At, B0); PG8_BAR; PG8_SCHED;
            PG8_STAGE(PG8_SB(1, 1), b3 + hstep, voffB);
            PG8_WAIT_V(6); PG8_BAR; PG8_MMA(1, 1, At, B1); PG8_BAR;
            }
        }
        if constexpr (ALIGN_EPI) { if (wr == 0) PG8_BAR; }
        if constexpr (!Epi::AFTER_DRAIN) { E(acc, cur, wr, wc, fr, fq); S.done(cur); }
        if (!has_next) break;
#pragma unroll
        for (int a = 0; a < 2; ++a)
#pragma unroll
            for (int b = 0; b < 2; ++b)
#pragma unroll
                for (int m = 0; m < 4; ++m)
#pragma unroll
                    for (int n = 0; n < 2; ++n) acc[a][b][m][n] = (f32x4){0.f, 0.f, 0.f, 0.f};
        cur = nxt; cA = nA; cB = nB; ++ui;
        if constexpr (ALIGN_EPI) { if (wr == 1) PG8_BAR; }
    }
    PG8_WAIT_V(0);
    if constexpr (!ALIGN_EPI) { if (wr == 0) PG8_BAR; }
    PG8_BAR;
    if constexpr (Epi::AFTER_DRAIN) { E.fused(acc, cur, wr, wc, fr, fq, lds, wid, lane); S.done(cur); }
#undef PG8_SA
#undef PG8_SB
#undef PG8_STAGE
#undef PG8_LDA
#undef PG8_LDB
#undef PG8_MMA
#undef PG8_WAIT_V
#undef PG8_WAIT_L
#undef PG8_BAR
#undef PG8_SCHED
}
}

namespace att {
typedef unsigned short bf16_t;
typedef short bf16x8 __attribute__((ext_vector_type(8)));
typedef short s16x4 __attribute__((ext_vector_type(4)));
typedef float f32x16 __attribute__((ext_vector_type(16)));
typedef float f32x4 __attribute__((ext_vector_type(4)));
typedef unsigned u32x4 __attribute__((ext_vector_type(4)));
typedef unsigned u32x2 __attribute__((ext_vector_type(2)));
#define ATT_LAS __attribute__((address_space(3)))
constexpr int KROWB = 144;
constexpr int KBYTES = 64 * KROWB;
template <int DV> struct Geo { static constexpr int VROWB = DV * 2 + 32, VBYTES = 64 * VROWB, BUF = KBYTES + VBYTES; };
typedef __bf16 bf16x2_t __attribute__((ext_vector_type(2)));
typedef float f32x2 __attribute__((ext_vector_type(2)));
typedef short v4i16_t __attribute__((ext_vector_type(4)));
__device__ __forceinline__ unsigned pk2(float lo, float hi) { f32x2 v = {lo, hi}; bf16x2_t b = __builtin_convertvector(v, bf16x2_t); return __builtin_bit_cast(unsigned, b); }
__device__ __forceinline__ s16x4 vtr(const ATT_LAS unsigned char* p) { return __builtin_bit_cast(s16x4, __builtin_amdgcn_ds_read_tr16_b64_v4i16((ATT_LAS v4i16_t*)p)); }
constexpr float THR = 8.0f;

template <int DV, bool HAS_REF>
__device__ __forceinline__ void core(ATT_LAS unsigned char* lds, const bf16_t* __restrict__ qp, const bf16_t* __restrict__ kp, const bf16_t* __restrict__ vp, long stride,
                                     int n0, int kt_lo, int kt_hi, int max_dist, float slope2, f32x16 (&o)[DV / 32], float& m, float& l) {
    constexpr int VROWB = Geo<DV>::VROWB, NVC = DV / 64;
    const int tid = opaque_tid(), lane = tid & 63, l32 = lane & 31, hi = lane >> 5; const int wid = __builtin_amdgcn_readfirstlane(tid >> 6);
    const int wq0 = n0 + wid * 32, qi = wq0 + l32;
    bf16x8 qf[4];
#pragma unroll
    for (int s = 0; s < 4; ++s) qf[s] = *(const bf16x8*)(qp + (long)qi * stride + s * 16 + hi * 8);
#pragma unroll
    for (int d0 = 0; d0 < DV / 32; ++d0)
#pragma unroll
        for (int r = 0; r < 16; ++r) o[d0][r] = 0.f;
    const int kkey = tid >> 3, kch = tid & 7;
    const bf16_t* kg = kp + (long)kkey * stride + kch * 8;
    const int vkey = (DV == 64) ? (tid >> 3) : (tid >> 4), vch = (DV == 64) ? (tid & 7) : (tid & 15);
    const bf16_t* vg = vp + (long)vkey * stride + vch * 8;
    const long tstep = 64 * stride;
    u32x4 kreg, vreg[NVC];
    kreg = *(const u32x4*)(kg + (long)(kt_hi - 1) * tstep);
#pragma unroll
    for (int j = 0; j < NVC; ++j) vreg[j] = *(const u32x4*)(vg + (long)(kt_hi - 1) * tstep + (long)j * 32 * stride);
    const int voff = (4 * hi + ((lane & 15) >> 2)) * VROWB + (16 * ((lane >> 4) & 1) + 4 * (lane & 3)) * 2;
    bool started = HAS_REF;
    int cur = 0;
    for (int kt = kt_hi - 1; kt >= kt_lo; --kt) {
        ATT_LAS unsigned char* Kb = lds + cur * Geo<DV>::BUF; ATT_LAS unsigned char* Vb = Kb + KBYTES;
        *(ATT_LAS u32x4*)(Kb + kkey * KROWB + kch * 16) = kreg;
#pragma unroll
        for (int j = 0; j < NVC; ++j) *(ATT_LAS u32x4*)(Vb + (vkey + 32 * j) * VROWB + vch * 16) = vreg[j];
        __syncthreads();
        if (kt > kt_lo) {
            kreg = *(const u32x4*)(kg + (long)(kt - 1) * tstep);
#pragma unroll
            for (int j = 0; j < NVC; ++j) vreg[j] = *(const u32x4*)(vg + (long)(kt - 1) * tstep + (long)j * 32 * stride);
        }
        const int k0 = kt * 64;
        const bool relevant = (k0 <= wq0 + 31) && (k0 + 63 >= wq0 - max_dist);
        if (relevant) {
            const int rel0 = k0 + 4 * hi - qi;
            const float base = slope2 * (float)rel0 - (started ? m : 0.f);
            f32x16 s0, s1;
#pragma unroll
            for (int r = 0; r < 16; ++r) { const float c = (float)((r & 3) + 8 * (r >> 2)); s0[r] = __builtin_fmaf(slope2, c, base); s1[r] = __builtin_fmaf(slope2, c + 32.f, base); }
#pragma unroll
            for (int s = 0; s < 4; ++s) {
                const bf16x8 ka = *(const ATT_LAS bf16x8*)(Kb + l32 * KROWB + s * 32 + hi * 16);
                const bf16x8 kb = *(const ATT_LAS bf16x8*)(Kb + (32 + l32) * KROWB + s * 32 + hi * 16);
                s0 = __builtin_amdgcn_mfma_f32_32x32x16_bf16(ka, qf[s], s0, 0, 0, 0);
                s1 = __builtin_amdgcn_mfma_f32_32x32x16_bf16(kb, qf[s], s1, 0, 0, 0);
            }
            const bool need_mask = (k0 + 63 > wq0) || (k0 < wq0 + 31 - max_dist);
            if (need_mask) {
#pragma unroll
                for (int r = 0; r < 16; ++r) {
                    const int rel = rel0 + (r & 3) + 8 * (r >> 2);
                    if (rel > 0 || rel < -max_dist) s0[r] = -INFINITY;
                    if (rel + 32 > 0 || rel + 32 < -max_dist) s1[r] = -INFINITY;
                }
            }
            float mx = fmaxf(s0[0], s1[0]);
#pragma unroll
            for (int r = 1; r < 16; ++r) mx = fmaxf(fmaxf(mx, s0[r]), s1[r]);
            mx = fmaxf(mx, __shfl_xor(mx, 32));
            if (!started) {
                m = mx;
#pragma unroll
                for (int r = 0; r < 16; ++r) { s0[r] -= mx; s1[r] -= mx; }
                started = true;
            } else if (__any(mx > THR)) {
                const float dl = fmaxf(mx, 0.f); m += dl;
                const float alpha = __builtin_amdgcn_exp2f(-dl);
                l *= alpha;
#pragma unroll
                for (int r = 0; r < 16; ++r) { s0[r] -= dl; s1[r] -= dl; }
#pragma unroll
                for (int d0 = 0; d0 < DV / 32; ++d0)
#pragma unroll
                    for (int r = 0; r < 16; ++r) o[d0][r] *= alpha;
            }
            float ps = 0.f;
#pragma unroll
            for (int r = 0; r < 16; ++r) { s0[r] = __builtin_amdgcn_exp2f(s0[r]); s1[r] = __builtin_amdgcn_exp2f(s1[r]); ps += s0[r] + s1[r]; }
            l += ps;
            u32x4 pw[4];
#pragma unroll
            for (int e = 0; e < 4; ++e) {
                pw[0][e] = pk2(s0[2 * e], s0[2 * e + 1]); pw[1][e] = pk2(s0[8 + 2 * e], s0[8 + 2 * e + 1]);
                pw[2][e] = pk2(s1[2 * e], s1[2 * e + 1]); pw[3][e] = pk2(s1[8 + 2 * e], s1[8 + 2 * e + 1]);
            }
#pragma unroll
            for (int ks = 0; ks < 4; ++ks) {
                const bf16x8 pf = __builtin_bit_cast(bf16x8, pw[ks]);
#pragma unroll
                for (int d0 = 0; d0 < DV / 32; ++d0) {
                    const ATT_LAS unsigned char* vr = Vb + voff + (16 * ks) * VROWB + d0 * 64;
                    const s16x4 lo = vtr(vr), hh = vtr(vr + 8 * VROWB);
                    const bf16x8 vf = (bf16x8){lo[0], lo[1], lo[2], lo[3], hh[0], hh[1], hh[2], hh[3]};
                    o[d0] = __builtin_amdgcn_mfma_f32_32x32x16_bf16(vf, pf, o[d0], 0, 0, 0);
                }
            }
        }
        cur ^= 1;
    }
    __syncthreads();
}
}

namespace cg = cooperative_groups;
typedef unsigned short bf16;
typedef float f32x4 __attribute__((ext_vector_type(4)));
typedef unsigned v4u __attribute__((ext_vector_type(4)));
typedef unsigned v2u __attribute__((ext_vector_type(2)));
#define LAS __attribute__((address_space(3)))
constexpr int NWAVES = 8;
constexpr int BATCH = 2, SEQ = 8192, D = 1024, DFF = 2816, M = BATCH * SEQ, DEPTH = 4;
constexpr float RMS_EPS = 1e-6f, LOG2E = 1.4426950408889634f, QSCALE = 0.125f * LOG2E;
constexpr size_t MiB = 1u << 20;
constexpr size_t WS_W = 0, WS_BIG = 185 * MiB, WS_H = 281 * MiB, WS_F = 313 * MiB, WS_O = 377 * MiB, WS_STATS = 409 * MiB, WS_LSE = 410 * MiB, WS_BAR = 411 * MiB, WS_END = 412 * MiB;
constexpr size_t W_GU = (size_t)2 * DFF * D, W_DN = (size_t)D * DFF, W_FFN = W_GU + W_DN;
constexpr size_t WO_AIN = 8 * W_FFN, W_AIN = (size_t)9216 * D, WO_AOUT = WO_AIN + 2 * W_AIN, W_SQ = (size_t)D * D;
constexpr size_t WO_BIN = WO_AOUT + 2 * W_SQ, W_BIN = (size_t)3072 * D, WO_BOUT = WO_BIN + W_BIN, WO_CIN = WO_BOUT + W_SQ, W_CIN = (size_t)1280 * D, WO_COUT = WO_CIN + W_CIN, WO_END = WO_COUT + W_SQ;
static_assert(WO_END * 2 <= WS_BIG, "weights fit");
constexpr int LDS_BYTES = 131072 + 1024, MISC_OFF = 131072;
#define XB_TMO      128
#define XB_XCNT(j)  (256  + 64 * (j))
#define XB_XSUB(j)  (1280 + 64 * (j))
#define XB_XGEN(j)  (2304 + 64 * (j))
#define XB_TOP      3328
#define XB_TOPGEN   3392
#define XCD_BAR_WORDS 3456
#define XB_SPIN_CAP (1u << 18)

__device__ __forceinline__ unsigned xb_ld(unsigned* p)              { return __hip_atomic_load(p, __ATOMIC_RELAXED, __HIP_MEMORY_SCOPE_AGENT); }
__device__ __forceinline__ unsigned xb_add(unsigned* p, unsigned v) { return __hip_atomic_fetch_add(p, v, __ATOMIC_RELAXED, __HIP_MEMORY_SCOPE_AGENT); }
__device__ __forceinline__ unsigned xb_xcc_id() { return (unsigned)__builtin_amdgcn_s_getreg((3 << 11) | 20) & 0xFu; }
#define XB_SPIN(cond, bar) do { unsigned _sp = 0; while (cond) { __builtin_amdgcn_s_sleep(1); \
    if ((++_sp & 255u) == 0u) { if (xb_ld(&(bar)[XB_TMO])) break; if (_sp > XB_SPIN_CAP) { atomicAdd(&(bar)[XB_TMO], 1u); break; } } } } while (0)

struct XcdBarrier {
    unsigned* bar; unsigned x;
    volatile LAS unsigned* st;
};

__device__ __forceinline__ XcdBarrier xcd_barrier_post(unsigned* bar, volatile LAS unsigned* st) {
    XcdBarrier b; b.bar = bar; b.x = xb_xcc_id(); b.st = st;
    if (threadIdx.x == 0) (void)xb_add(&bar[XB_XCNT(b.x)], 1u);
    return b;
}
__device__ __forceinline__ void xcd_barrier_complete(unsigned* bar, unsigned x, unsigned& nloc, unsigned& nx) {
    const unsigned G = gridDim.x * gridDim.y * gridDim.z;
    unsigned sum, cnt, mine, sp = 0u;
    for (;;) {
        sum = 0u; cnt = 0u; mine = 0u;
#pragma unroll
        for (unsigned j = 0; j < 16; ++j) { const unsigned c = xb_ld(&bar[XB_XCNT(j)]); sum += c; cnt += (c > 0u) ? 1u : 0u; mine = (j == x) ? c : mine; }
        if (sum == G) break;
        __builtin_amdgcn_s_sleep(1);
        if ((++sp & 255u) == 0u) { if (xb_ld(&bar[XB_TMO])) break; if (sp > XB_SPIN_CAP) { atomicAdd(&bar[XB_TMO], 1u); break; } }
    }
    nloc = mine > 0u ? mine : 1u; nx = cnt > 0u ? cnt : 1u;
}

__device__ __forceinline__ void xcd_barrier(const XcdBarrier& b) {
    asm volatile("s_waitcnt vmcnt(0)" ::: "memory");
    __syncthreads();
    if (threadIdx.x == 0) {
        unsigned* bar = b.bar;
        __builtin_amdgcn_s_waitcnt(0);
        unsigned nloc = b.st[0], nx = b.st[1];
        if (nloc == 0u) { xcd_barrier_complete(bar, b.x, nloc, nx); b.st[0] = nloc; b.st[1] = nx; }
        const unsigned old = xb_add(&bar[XB_XSUB(b.x)], 1u);
        const unsigned gen = old / nloc;
        if (old + 1u == (gen + 1u) * nloc) {
            __builtin_amdgcn_fence(__ATOMIC_RELEASE, "agent");
            asm volatile("s_waitcnt vmcnt(0)" ::: "memory");
            const unsigned og = xb_add(&bar[XB_TOP], 1u);
            const unsigned tg = og / nx;
            if (og + 1u == (tg + 1u) * nx) xb_add(&bar[XB_TOPGEN], 1u);
            else XB_SPIN(xb_ld(&bar[XB_TOPGEN]) == tg, bar);
            __builtin_amdgcn_fence(__ATOMIC_ACQUIRE, "agent");
            xb_add(&bar[XB_XGEN(b.x)], 1u);
            asm volatile("s_waitcnt vmcnt(0)" ::: "memory");
        } else {
            XB_SPIN(xb_ld(&bar[XB_XGEN(b.x)]) == gen, bar);
            __builtin_amdgcn_fence(__ATOMIC_ACQUIRE, "agent");
            asm volatile("s_waitcnt vmcnt(0)" ::: "memory");
        }
    }
    __syncthreads();
}


__device__ __forceinline__ float wave_sum(float v) {
#pragma unroll
    for (int o = 1; o < 64; o <<= 1) v += __shfl_xor(v, o);
    return v;
}
__device__ __forceinline__ unsigned pk2(float lo, float hi) { return att::pk2(lo, hi); }

__device__ __forceinline__ void transpose_item(const float* __restrict__ W, int K, int N, bf16* WT, LAS float* scr, int item, int lane, int mode) {
    const int nblk = N / 32, kb = item / nblk, nb = item % nblk, k0 = 64 * kb, n0 = 32 * nb;
    int drow0 = n0;
    if (mode) drow0 = 256 * (n0 >> 7) + (n0 & 127) + (mode == 2 ? 128 : 0);
#pragma unroll 8
    for (int i = 0; i < 32; ++i) { const int kk = 2 * i + (lane >> 5); scr[kk * 33 + (lane & 31)] = W[(size_t)(k0 + kk) * N + n0 + (lane & 31)]; }
    asm volatile("s_waitcnt lgkmcnt(0)" ::: "memory");
    const int c = lane & 7;
#pragma unroll
    for (int j = 0; j < 4; ++j) { const int n = (lane >> 3) + 8 * j; const LAS float* s = scr + (8 * c) * 33 + n;
        v4u o; o.x = pk2(s[0 * 33], s[1 * 33]); o.y = pk2(s[2 * 33], s[3 * 33]); o.z = pk2(s[4 * 33], s[5 * 33]); o.w = pk2(s[6 * 33], s[7 * 33]);
        *(v4u*)(WT + (size_t)(drow0 + n) * K + k0 + 8 * c) = o; }
    asm volatile("s_waitcnt lgkmcnt(0)" ::: "memory");
}

struct Args {
    const float* x; const float* norm_pre; const float* norm_post; const float* wg; const float* wu; const float* wd;
    const float* a_in; const float* a_out; const float* b_in; const float* b_out; const float* b_lambda; const float* b_subln;
    const float* c_in; const float* c_bin; const float* c_out; const float* c_sinks;
    float* out; unsigned char* ws;
};

__device__ __forceinline__ void rowpass(const float* F, const float* stats, const float* xin, float* xout, const float* gpost, float coef, const float* gpre, bf16* hout, int gw, int NGW, int lane) {
    for (int m = gw; m < M; m += NGW) {
        const f32x4* fr = (const f32x4*)(F + (size_t)m * D) + lane; const f32x4* xr = (const f32x4*)(xin + (size_t)m * D) + lane;
        float st = (lane < 16) ? stats[(size_t)m * 16 + lane] : 0.f;
        f32x4 f[4], x[4];
#pragma unroll
        for (int j = 0; j < 4; ++j) { f[j] = fr[64 * j]; x[j] = xr[64 * j]; }
        const float rstd = coef * __builtin_amdgcn_rsqf(wave_sum(st) * (1.f / D) + RMS_EPS);
        float s2 = 0.f;
#pragma unroll
        for (int j = 0; j < 4; ++j) { const f32x4 g = *((const f32x4*)gpost + lane + 64 * j); x[j] = x[j] + f[j] * g * rstd; s2 += (x[j].x * x[j].x + x[j].y * x[j].y) + (x[j].z * x[j].z + x[j].w * x[j].w);
            *((f32x4*)(xout + (size_t)m * D) + lane + 64 * j) = x[j]; }
        if (gpre) {
            const float r2 = __builtin_amdgcn_rsqf(wave_sum(s2) * (1.f / D) + RMS_EPS);
            v2u* o8 = (v2u*)(hout + (size_t)m * D) + lane;
#pragma unroll
            for (int j = 0; j < 4; ++j) { const f32x4 g = *((const f32x4*)gpre + lane + 64 * j); const f32x4 y = x[j] * g * r2; v2u w; w.x = pk2(y.x, y.y); w.y = pk2(y.z, y.w); o8[64 * j] = w; }
        }
    }
}

__device__ __forceinline__ float alibi_slope(int h, int nheads) { return exp2f(-8.0f * (float)(h + 1) / (float)nheads); }

__device__ __forceinline__ void prologue_phase(const Args& a, LAS unsigned char* lds, int gw, int NGW, int wave, int lane) {
    bf16* Wt = (bf16*)(a.ws + WS_W); bf16* Hb = (bf16*)(a.ws + WS_H);
    LAS float* scr = (LAS float*)(lds + wave * 16384);
    constexpr int I_FFN = 1408, N_FFN = 24 * I_FFN, I_AIN = 16 * 288, I_SQ = 512, I_BIN = 16 * 96, I_CIN = 16 * 40;
    constexpr int NITEMS = N_FFN + 2 * I_AIN + 2 * I_SQ + I_BIN + I_SQ + I_CIN + I_SQ;
    for (int it = gw; it < NITEMS; it += NGW) {
        int r = it; const float* src; bf16* dst; int K = D, N = D, mode = 0;
        if (r < N_FFN) { const int mi = r / I_FFN, f = mi / 3, kind = mi % 3; r -= mi * I_FFN;
            if (kind == 0) { src = a.wg + (size_t)f * D * DFF; dst = Wt + f * W_FFN; N = DFF; mode = 1; }
            else if (kind == 1) { src = a.wu + (size_t)f * D * DFF; dst = Wt + f * W_FFN; N = DFF; mode = 2; }
            else { src = a.wd + (size_t)f * DFF * D; dst = Wt + f * W_FFN + W_GU; K = DFF; }
        } else { r -= N_FFN;
            if (r < 2 * I_AIN) { const int j = r / I_AIN; r -= j * I_AIN; src = a.a_in + (size_t)j * D * 9216; dst = Wt + WO_AIN + j * W_AIN; N = 9216; }
            else { r -= 2 * I_AIN;
                if (r < 2 * I_SQ) { const int j = r / I_SQ; r -= j * I_SQ; src = a.a_out + (size_t)j * D * D; dst = Wt + WO_AOUT + j * W_SQ; }
                else { r -= 2 * I_SQ;
                    if (r < I_BIN) { src = a.b_in; dst = Wt + WO_BIN; N = 3072; }
                    else { r -= I_BIN;
                        if (r < I_SQ) { src = a.b_out; dst = Wt + WO_BOUT; }
                        else { r -= I_SQ;
                            if (r < I_CIN) { src = a.c_in; dst = Wt + WO_CIN; N = 1280; }
                            else { r -= I_CIN; src = a.c_out; dst = Wt + WO_COUT; } } } } } }
        transpose_item(src, K, N, dst, scr, r, lane, mode);
    }
    for (int m = gw; m < M; m += NGW) {
        const f32x4* xr = (const f32x4*)(a.x + (size_t)m * D) + lane; f32x4 x[4]; float s2 = 0.f;
#pragma unroll
        for (int j = 0; j < 4; ++j) { x[j] = xr[64 * j]; s2 += (x[j].x * x[j].x + x[j].y * x[j].y) + (x[j].z * x[j].z + x[j].w * x[j].w); }
        const float r2 = __builtin_amdgcn_rsqf(wave_sum(s2) * (1.f / D) + RMS_EPS);
        v2u* o8 = (v2u*)(Hb + (size_t)m * D) + lane;
#pragma unroll
        for (int j = 0; j < 4; ++j) { const f32x4 g = *((const f32x4*)a.norm_pre + lane + 64 * j); const f32x4 y = x[j] * g * r2; v2u w; w.x = pk2(y.x, y.y); w.y = pk2(y.z, y.w); o8[64 * j] = w; }
    }
}

__device__ __forceinline__ void attn_a_phase(const Args& a, LAS unsigned char* lds, int gi, int bid, int G, int wave, int lane) {
    const bf16* BIG = (const bf16*)(a.ws + WS_BIG); float* Fb = (float*)(a.ws + WS_F); bf16* Ob = (bf16*)(a.ws + WS_O); float* lse_run = (float*)(a.ws + WS_LSE);
    const int dil = (gi == 0) ? 1 : (gi == 1) ? 4 : 16; const int nsub = SEQ / dil, nqb = nsub / 256;
    for (int u = bid; u < 1024; u += G) {
        const int qb = u % nqb; int t = u / nqb; const int cls = t % dil; t /= dil; const int h = t & 15, b = t >> 4;
        const bf16* base = BIG + ((size_t)b * SEQ + cls) * 3072 + h * 64;
        const int n0 = qb * 256; const int kt_lo = (n0 >= 128) ? (n0 / 64 - 2) : 0, kt_hi = n0 / 64 + 4;
        const float slope2 = alibi_slope(h, 16) * (float)dil * LOG2E;
        att::f32x16 o[2]; float mrun = -1e30f, lrun = 0.f;
        att::core<64, false>(lds, base, base + 1024, base + 2048, (long)dil * 3072, n0, kt_lo, kt_hi, 128, slope2, o, mrun, lrun);
        const int l32 = lane & 31, hi = lane >> 5;
        lrun += __shfl_xor(lrun, 32);
        const float inv = 1.f / lrun; float lse = mrun + __log2f(lrun);
        const size_t tok = (size_t)b * SEQ + (size_t)(n0 + wave * 32 + l32) * dil + cls;
        float w_old = 0.f, w_new = 1.f;
        if (gi > 0) { const float lo = lse_run[tok * 16 + h]; const float mm = fmaxf(lo, lse); const float e0 = __builtin_amdgcn_exp2f(lo - mm), e1 = __builtin_amdgcn_exp2f(lse - mm);
            const float rs = 1.f / (e0 + e1); w_old = e0 * rs; w_new = e1 * rs; lse = mm + __log2f(e0 + e1); }
        if (gi < 2 && hi == 0) lse_run[tok * 16 + h] = lse;
        w_new *= inv;
#pragma unroll
        for (int d0 = 0; d0 < 2; ++d0)
#pragma unroll
            for (int gq = 0; gq < 4; ++gq) {
                const int d = d0 * 32 + 8 * gq + 4 * hi;
                f32x4 v = {o[d0][4 * gq] * w_new, o[d0][4 * gq + 1] * w_new, o[d0][4 * gq + 2] * w_new, o[d0][4 * gq + 3] * w_new};
                float* fp = Fb + tok * D + h * 64 + d;
                if (gi > 0) { const f32x4 old = *(const f32x4*)fp; v = v + old * w_old; }
                if (gi < 2) *(f32x4*)fp = v;
                else { v2u w; w.x = pk2(v.x, v.y); w.y = pk2(v.z, v.w); *(v2u*)(Ob + tok * D + h * 64 + d) = w; }
            }
    }
}

__device__ __forceinline__ void attn_b_phase(const Args& a, LAS unsigned char* lds, int layer, int bid, int G, int wave, int lane) {
    const bf16* BIG = (const bf16*)(a.ws + WS_BIG); float* Fb = (float*)(a.ws + WS_F); bf16* Ob = (bf16*)(a.ws + WS_O);
    const int jm = layer / 3;
    const float lambda_init = 0.8f - 0.6f * expf(-0.3f * (float)layer);
    const float* lam = a.b_lambda + (size_t)jm * 256;
    const float d1 = wave_sum(lam[lane] * lam[64 + lane]), d2 = wave_sum(lam[128 + lane] * lam[192 + lane]);
    const float lam_full = expf(d1) - expf(d2) + lambda_init;
    const float* subln = a.b_subln + (size_t)jm * 128;
    const int l32 = lane & 31, hi = lane >> 5;
    for (int u2 = bid; u2 < 1024; u2 += G) {
        const int u = u2 & 255, ps = u2 >> 8; const int c = ps & 1;
        const int s = u & 15, h = (u >> 4) & 7, b = u >> 7;
        const int qb = (ps >> 1) ? 31 - s : s; const int n0 = qb * 256;
        const size_t tok = (size_t)b * SEQ + n0 + wave * 32 + l32;
        const int hh = 2 * h + c;
        const bf16* base = BIG + (size_t)b * SEQ * 3072;
        const float slope2 = alibi_slope(h, 8) * LOG2E;
        att::f32x16 o[4]; float mrun = -1e30f, lrun = 0.f;
        att::core<128, false>(lds, base + hh * 64, base + 1024 + hh * 64, base + 2048 + h * 128, 3072L, n0, 0, n0 / 64 + 4, 1 << 30, slope2, o, mrun, lrun);
        lrun += __shfl_xor(lrun, 32);
        const float inv = 1.f / lrun;
        if (c == 0) {
#pragma unroll
            for (int d0 = 0; d0 < 4; ++d0)
#pragma unroll
                for (int gq = 0; gq < 4; ++gq) { const int d = d0 * 32 + 8 * gq + 4 * hi;
                    *(f32x4*)(Fb + tok * D + h * 128 + d) = (f32x4){o[d0][4 * gq] * inv, o[d0][4 * gq + 1] * inv, o[d0][4 * gq + 2] * inv, o[d0][4 * gq + 3] * inv}; }
        } else {
            const float sc2 = -lam_full * inv; float ss = 0.f;
#pragma unroll
            for (int d0 = 0; d0 < 4; ++d0)
#pragma unroll
                for (int gq = 0; gq < 4; ++gq) { const int d = d0 * 32 + 8 * gq + 4 * hi; const f32x4 o1 = *(const f32x4*)(Fb + tok * D + h * 128 + d);
#pragma unroll
                    for (int j = 0; j < 4; ++j) { const float df = o1[j] + sc2 * o[d0][4 * gq + j]; o[d0][4 * gq + j] = df; ss += df * df; } }
            ss += __shfl_xor(ss, 32);
            const float rs = __builtin_amdgcn_rsqf(ss * (1.f / 128.f) + RMS_EPS) * (1.f - lambda_init);
#pragma unroll
            for (int d0 = 0; d0 < 4; ++d0)
#pragma unroll
                for (int gq = 0; gq < 4; ++gq) { const int d = d0 * 32 + 8 * gq + 4 * hi; const f32x4 gs = *(const f32x4*)(subln + d);
                    v2u w; w.x = pk2(o[d0][4 * gq] * rs * gs.x, o[d0][4 * gq + 1] * rs * gs.y); w.y = pk2(o[d0][4 * gq + 2] * rs * gs.z, o[d0][4 * gq + 3] * rs * gs.w);
                    *(v2u*)(Ob + tok * D + h * 128 + d) = w; }
        }
    }
}

__device__ __forceinline__ void attn_c_phase(const Args& a, LAS unsigned char* lds, int jm, int bid, int G, int wave, int lane) {
    const bf16* BIG = (const bf16*)(a.ws + WS_BIG); bf16* Ob = (bf16*)(a.ws + WS_O);
    for (int u = bid; u < 1024; u += G) {
        const int qb = u & 31, h = (u >> 5) & 15, b = u >> 9; const int kvh = h >> 3;
        const bf16* base = BIG + (size_t)b * SEQ * 1280;
        const int n0 = qb * 256; const int kt_lo = (n0 >= 128) ? (n0 / 64 - 2) : 0, kt_hi = n0 / 64 + 4;
        const float slope2 = alibi_slope(h, 16) * LOG2E;
        const int l32 = lane & 31, hi = lane >> 5;
        att::f32x16 o[2]; float mrun = a.c_sinks[jm * 16 + h] * LOG2E, lrun = (hi == 0) ? 1.f : 0.f;
        att::core<64, true>(lds, base + h * 64, base + 1024 + kvh * 64, base + 1152 + kvh * 64, 1280L, n0, kt_lo, kt_hi, 127, slope2, o, mrun, lrun);
        lrun += __shfl_xor(lrun, 32);
        const float inv = 1.f / lrun;
        const size_t tok = (size_t)b * SEQ + n0 + wave * 32 + l32;
#pragma unroll
        for (int d0 = 0; d0 < 2; ++d0)
#pragma unroll
            for (int gq = 0; gq < 4; ++gq) { const int d = d0 * 32 + 8 * gq + 4 * hi;
                v2u w; w.x = pk2(o[d0][4 * gq] * inv, o[d0][4 * gq + 1] * inv); w.y = pk2(o[d0][4 * gq + 2] * inv, o[d0][4 * gq + 3] * inv);
                *(v2u*)(Ob + tok * D + h * 64 + d) = w; }
    }
}

constexpr int STEPS = 14;
__global__ void __launch_bounds__(NWAVES * 64, 2) mega_fwd(Args a) {
    extern __shared__ __attribute__((aligned(16))) unsigned char lds_raw[];
    LAS unsigned char* lds = (LAS unsigned char*)lds_raw;
    cg::grid_group grid = cg::this_grid();
#ifdef PROBE_MASK
    unsigned long long pr_acc = 0, pr_prev = __builtin_amdgcn_s_memrealtime();
#define PROBE_TICK(cls) do { const unsigned long long now_ = __builtin_amdgcn_s_memrealtime(); if ((PROBE_MASK >> (cls)) & 1) pr_acc += now_ - pr_prev; pr_prev = now_; } while (0)
#else
#define PROBE_TICK(cls) do {} while (0)
#endif
    unsigned* barw = (unsigned*)(a.ws + WS_BAR);
    if (blockIdx.x == 0) for (int i = threadIdx.x; i < XCD_BAR_WORDS; i += NWAVES * 64) __hip_atomic_store(barw + i, 0u, __ATOMIC_RELAXED, __HIP_MEMORY_SCOPE_AGENT);
    if (threadIdx.x < 32) ((volatile LAS unsigned*)(lds + MISC_OFF))[threadIdx.x] = 0u;
    prologue_phase(a, lds, blockIdx.x * NWAVES + __builtin_amdgcn_readfirstlane(threadIdx.x >> 6), gridDim.x * NWAVES, __builtin_amdgcn_readfirstlane(threadIdx.x >> 6), threadIdx.x & 63);
    grid.sync();
    const XcdBarrier bar = xcd_barrier_post(barw, (volatile LAS unsigned*)(lds + MISC_OFF) + 8);
    PROBE_TICK(0);
#pragma unroll 1
    for (int ph = 0; ph < DEPTH * STEPS; ++ph) {
        const int layer = ph / STEPS, st = ph % STEPS; const int kind = layer % 3, jm = layer / 3;
        if (kind != 0 && st >= 5 && st <= 8) continue;
        const int G = gridDim.x, bid = blockIdx.x; const int tid_ = opaque_tid(); const int lane = tid_ & 63; const int wave = __builtin_amdgcn_readfirstlane(tid_ >> 6);
        unsigned char* ws = a.ws;
        bf16* Wt = (bf16*)(ws + WS_W);
        if (st == 0 || st == 11) {
            const int f = layer * 2 + (st == 11);
            pg8::Gemm g{(const bf16*)(ws + WS_H), Wt + f * W_FFN, M, 2 * DFF, D}; pg8::StaticOrder S; S.init(M, 2 * DFF, G, bid);
            pg8::EpiSwiGLU E{(bf16*)(ws + WS_BIG), DFF};
            pg8::gemm_phase<pg8::EpiSwiGLU, pg8::StaticOrder, true, true>(lds, g, S, E);
        } else if (st == 1 || st == 12 || st == 9) {
            pg8::Gemm g; g.M = M; g.N = D;
            if (st == 9) { g.A = (const bf16*)(ws + WS_O); g.K = D; g.Bt = (kind == 0) ? Wt + WO_AOUT + jm * W_SQ : (kind == 1) ? Wt + WO_BOUT : Wt + WO_COUT; }
            else { const int f = layer * 2 + (st == 12); g.A = (const bf16*)(ws + WS_BIG); g.K = DFF; g.Bt = Wt + f * W_FFN + W_GU; }
            pg8::StaticOrder S; S.init(M, D, G, bid);
            pg8::EpiF32Stats E{(float*)(ws + WS_F), D, (float*)(ws + WS_STATS)};
            pg8::gemm_phase<pg8::EpiF32Stats, pg8::StaticOrder, true, true>(lds, g, S, E);
        } else if (st == 3 || st == 5 || st == 7) {
            pg8::Gemm g; g.A = (const bf16*)(ws + WS_H); g.M = M; g.K = D; const float* bias = nullptr;
            if (kind == 0) { g.N = 3072; g.Bt = Wt + WO_AIN + jm * W_AIN + (size_t)((st - 3) >> 1) * 3072 * D; }
            else if (kind == 1) { g.N = 3072; g.Bt = Wt + WO_BIN; }
            else { g.N = 1280; g.Bt = Wt + WO_CIN; bias = a.c_bin + (size_t)jm * 1280; }
            pg8::StaticOrder S; S.init(M, g.N, G, bid);
            pg8::EpiProj E{(bf16*)(ws + WS_BIG), g.N, bias, QSCALE};
            pg8::gemm_phase<pg8::EpiProj, pg8::StaticOrder, true, true>(lds, g, S, E);
        } else if (st == 4 || st == 6 || st == 8) {
            if (kind == 0) attn_a_phase(a, lds, (st - 4) >> 1, bid, G, wave, lane);
            else if (kind == 1) attn_b_phase(a, lds, layer, bid, G, wave, lane);
            else attn_c_phase(a, lds, jm, bid, G, wave, lane);
        } else {
            const int gw = bid * NWAVES + wave, NGW = G * NWAVES;
            const int pi = (st == 2) ? 0 : (st == 10) ? 1 : 2;
            const float* gpre = (pi < 2) ? a.norm_pre + (size_t)(layer * 3 + pi + 1) * D : (layer + 1 < DEPTH ? a.norm_pre + (size_t)((layer + 1) * 3) * D : nullptr);
            const float* xin = (ph == 2) ? a.x : a.out;
            rowpass((const float*)(ws + WS_F), (const float*)(ws + WS_STATS), xin, a.out, a.norm_post + (size_t)(layer * 3 + pi) * D, (pi == 1) ? 1.0f : 0.5f, gpre, (bf16*)(ws + WS_H), gw, NGW, lane);
        }
        if (ph != DEPTH * STEPS - 1) xcd_barrier(bar);
        PROBE_TICK((st == 0 || st == 11) ? 1 : (st == 1 || st == 12) ? 2 : (st == 2 || st == 10 || st == 13) ? 3 : (st == 3 || st == 5 || st == 7) ? 4 : (st == 9) ? 8 : 5 + kind);
    }
#ifdef PROBE_MASK
    if (blockIdx.x == 0) { const unsigned long long t0_ = __builtin_amdgcn_s_memrealtime(); while (__builtin_amdgcn_s_memrealtime() - t0_ < pr_acc) __builtin_amdgcn_s_sleep(8); }
#endif
}

extern "C" void kernel_launch(void* const* d_in, const int* in_sizes, int n_in, void* d_out, int out_size, void* d_ws, size_t ws_size, hipStream_t stream) {
    static int grid_blocks = 0;
    if (grid_blocks == 0) {
        if (n_in != 16 || in_sizes[0] != M * D || out_size != M * D || ws_size < WS_END) { fprintf(stderr, "kernel_launch: unexpected shapes / workspace (%d inputs, ws %zu)\n", n_in, ws_size); grid_blocks = -1; return; }
        int dev = 0, cus = 0, per_cu = 0;
        hipGetDevice(&dev);
        hipDeviceGetAttribute(&cus, hipDeviceAttributeMultiprocessorCount, dev);
        if (hipFuncSetAttribute((const void*)mega_fwd, hipFuncAttributeMaxDynamicSharedMemorySize, LDS_BYTES) != hipSuccess) { fprintf(stderr, "hipFuncSetAttribute failed\n"); grid_blocks = -1; return; }
        if (hipOccupancyMaxActiveBlocksPerMultiprocessor(&per_cu, (const void*)mega_fwd, NWAVES * 64, LDS_BYTES) != hipSuccess || per_cu < 1) { fprintf(stderr, "occupancy query failed (%d)\n", per_cu); per_cu = 1; }
        (void)hipGetLastError();
        grid_blocks = cus * per_cu;
    }
    if (grid_blocks < 0) return;
    Args a{};
    a.x = (const float*)d_in[0]; a.norm_pre = (const float*)d_in[1]; a.norm_post = (const float*)d_in[2]; a.wg = (const float*)d_in[3]; a.wu = (const float*)d_in[4]; a.wd = (const float*)d_in[5];
    a.a_in = (const float*)d_in[6]; a.a_out = (const float*)d_in[7]; a.b_in = (const float*)d_in[8]; a.b_out = (const float*)d_in[9]; a.b_lambda = (const float*)d_in[10]; a.b_subln = (const float*)d_in[11];
    a.c_in = (const float*)d_in[12]; a.c_bin = (const float*)d_in[13]; a.c_out = (const float*)d_in[14]; a.c_sinks = (const float*)d_in[15];
    a.out = (float*)d_out; a.ws = (unsigned char*)d_ws;
    void* args[] = {&a};
    hipError_t e = hipLaunchCooperativeKernel((const void*)mega_fwd, dim3(grid_blocks), dim3(NWAVES * 64), args, LDS_BYTES, stream);
    if (e != hipSuccess) fprintf(stderr, "cooperative launch failed: %s (grid %d)\n", hipGetErrorString(e), grid_blocks);
}
```
